# Optimizing an MI355X kernel written in HIP

```python
import math
import jax, jax.numpy as jnp
from jax import lax
import numpy as np

D_MODEL = 1024
BATCH = 4
SEQ = 8192
DEPTH = 2

N_MIXERS = 2
S5_GROUP = 16
S5_GROUPS = D_MODEL // S5_GROUP
S5_STATE = 64
SCAN_CHUNK = 128
DT_MIN = 1e-3
DT_MAX = 1e-1
CONV_WIDTH = 3
D_FF = ((11 * D_MODEL // 4 + 127) // 128) * 128
N_A_LAYERS = (DEPTH + 1) // 2
N_B_LAYERS = DEPTH // 2
RMS_EPS = 1e-6

kernel_name = "hybrid_s5_shortconv_convffn"


def rmsnorm(x, g):
    xf = x.astype(jnp.float32)
    y = xf * lax.rsqrt(jnp.mean(xf * xf, axis=-1, keepdims=True) + RMS_EPS)
    return (y * g.astype(jnp.float32)).astype(x.dtype)


def causal_dwconv(x, w):
    k_w = w.shape[0]
    seq = x.shape[1]
    xp = jnp.pad(x, ((0, 0), (k_w - 1, 0), (0, 0)))
    y = xp[:, 0:seq] * w[0]
    for k in range(1, k_w):
        y = y + xp[:, k:k + seq] * w[k]
    return y


def _ssm_combine(left, right):
    ar_l, ai_l, br_l, bi_l = left
    ar_r, ai_r, br_r, bi_r = right
    return (ar_r * ar_l - ai_r * ai_l,
            ar_r * ai_l + ai_r * ar_l,
            ar_r * br_l - ai_r * bi_l + br_r,
            ar_r * bi_l + ai_r * br_l + bi_r)


def s5_mixer(u, a_re, a_im, log_dt, b_re, b_im, c_re, c_im, d_skip, w_glu):
    f32 = jnp.float32
    bsz, seq, _ = u.shape
    lam_r = a_re.astype(f32)
    lam_i = a_im.astype(f32)
    dt = jnp.exp(log_dt.astype(f32))[:, None]
    mag = jnp.exp(lam_r * dt)
    ab_r = mag * jnp.cos(lam_i * dt)
    ab_i = mag * jnp.sin(lam_i * dt)
    den = lam_r * lam_r + lam_i * lam_i
    nr = ab_r - 1.0
    g_r = ((nr * lam_r + ab_i * lam_i) / den)[..., None]
    g_i = ((ab_i * lam_r - nr * lam_i) / den)[..., None]
    br = b_re.astype(f32)
    bi = b_im.astype(f32)
    bb_r = g_r * br - g_i * bi
    bb_i = g_r * bi + g_i * br
    cr = c_re.astype(f32)
    ci = c_im.astype(f32)
    steps = jnp.arange(1, SCAN_CHUNK + 1, dtype=f32)[:, None, None]
    pmag = jnp.exp(lam_r * dt * steps)
    pw_r = pmag * jnp.cos(lam_i * dt * steps)
    pw_i = pmag * jnp.sin(lam_i * dt * steps)
    a_blk_r = jnp.broadcast_to(ab_r, (bsz, SCAN_CHUNK, S5_GROUPS, S5_STATE))
    a_blk_i = jnp.broadcast_to(ab_i, (bsz, SCAN_CHUNK, S5_GROUPS, S5_STATE))

    n_chunks = seq // SCAN_CHUNK
    uf = u.astype(f32)
    uc = uf.reshape(bsz, n_chunks, SCAN_CHUNK, S5_GROUPS, S5_GROUP).transpose(1, 0, 2, 3, 4)

    def chunk_step(carry, u_blk):
        h0_r, h0_i = carry
        bu_r = jnp.einsum('btgh,gph->btgp', u_blk, bb_r)
        bu_i = jnp.einsum('btgh,gph->btgp', u_blk, bb_i)
        _, _, loc_r, loc_i = lax.associative_scan(
            _ssm_combine, (a_blk_r, a_blk_i, bu_r, bu_i), axis=1)
        h_r = loc_r + pw_r * h0_r[:, None] - pw_i * h0_i[:, None]
        h_i = loc_i + pw_r * h0_i[:, None] + pw_i * h0_r[:, None]
        y = jnp.einsum('btgp,ghp->btgh', h_r, cr) - jnp.einsum('btgp,ghp->btgh', h_i, ci)
        return (h_r[:, -1], h_i[:, -1]), y

    h_init = (jnp.zeros((bsz, S5_GROUPS, S5_STATE), f32),
              jnp.zeros((bsz, S5_GROUPS, S5_STATE), f32))
    _, ys = lax.scan(chunk_step, h_init, uc)
    y = ys.transpose(1, 0, 2, 3, 4).reshape(bsz, seq, D_MODEL)
    y = y + d_skip.astype(f32) * uf
    z = jax.nn.gelu(y)
    za, zg = jnp.split(z @ w_glu.astype(f32), 2, axis=-1)
    return (za * jax.nn.sigmoid(zg)).astype(u.dtype)


def shortconv_mixer(u, w_in, conv_w, w_out):
    b_gate, c_gate, h = jnp.split(u @ w_in, 3, axis=-1)
    v = causal_dwconv(c_gate * h, conv_w)
    return (b_gate * v) @ w_out


def conv_ffn(u, w_up, conv_w, conv_b, w_down):
    g, v = jnp.split(u @ w_up, 2, axis=-1)
    g = causal_dwconv(g, conv_w) + conv_b
    return (jax.nn.silu(g) * v) @ w_down


def setup_inputs(seed: int = 0) -> dict:
    key = jax.random.key(seed)
    ks = jax.random.split(key, 24)
    f32 = jnp.float32
    d = D_MODEL
    g, p, h, f = S5_GROUPS, S5_STATE, S5_GROUP, D_FF
    na, nb = N_A_LAYERS, N_B_LAYERS
    nrm = lambda k, s, sc: jax.random.normal(k, s, f32) * sc
    a_im_base = jnp.arange(p, dtype=f32) * jnp.pi
    return {
        "x": nrm(ks[0], (BATCH, SEQ, d), 1.0),
        "norm_mix": 1.0 + nrm(ks[1], (DEPTH, d), 0.02),
        "norm_ffn": 1.0 + nrm(ks[2], (DEPTH, d), 0.02),
        "norm_final": 1.0 + nrm(ks[3], (d,), 0.02),
        "s5_a_re": -0.5 + nrm(ks[4], (na, g, p), 0.01),
        "s5_a_im": a_im_base + nrm(ks[5], (na, g, p), 0.01),
        "s5_log_dt": jax.random.uniform(ks[6], (na, g), f32,
                                        minval=math.log(DT_MIN), maxval=math.log(DT_MAX)),
        "s5_b_re": nrm(ks[7], (na, g, p, h), (2.0 * h) ** -0.5),
        "s5_b_im": nrm(ks[8], (na, g, p, h), (2.0 * h) ** -0.5),
        "s5_c_re": nrm(ks[9], (na, g, h, p), (1.0 * p) ** -0.5),
        "s5_c_im": nrm(ks[10], (na, g, h, p), (1.0 * p) ** -0.5),
        "s5_d": nrm(ks[11], (na, d), 1.0),
        "s5_w_glu": nrm(ks[12], (na, d, 2 * d), d ** -0.5),
        "sc_w_in": nrm(ks[13], (nb, d, 3 * d), d ** -0.5),
        "sc_conv_w": nrm(ks[14], (nb, CONV_WIDTH, d), CONV_WIDTH ** -0.5),
        "sc_w_out": nrm(ks[15], (nb, d, d), d ** -0.5),
        "ffn_w_up": nrm(ks[16], (DEPTH, d, 2 * f), d ** -0.5),
        "ffn_conv_w": nrm(ks[17], (DEPTH, CONV_WIDTH, f), CONV_WIDTH ** -0.5),
        "ffn_conv_b": nrm(ks[18], (DEPTH, f), 0.01),
        "ffn_w_down": nrm(ks[19], (DEPTH, f, d), f ** -0.5),
    }


def reference(x, norm_mix, norm_ffn, norm_final, s5_a_re, s5_a_im, s5_log_dt,
              s5_b_re, s5_b_im, s5_c_re, s5_c_im, s5_d, s5_w_glu,
              sc_w_in, sc_conv_w, sc_w_out,
              ffn_w_up, ffn_conv_w, ffn_conv_b, ffn_w_down):
    h = x
    for i in range(DEPTH):
        j = i // N_MIXERS
        u = rmsnorm(h, norm_mix[i])
        if i % N_MIXERS == 0:
            mix = s5_mixer(u, s5_a_re[j], s5_a_im[j], s5_log_dt[j], s5_b_re[j], s5_b_im[j],
                           s5_c_re[j], s5_c_im[j], s5_d[j], s5_w_glu[j])
        else:
            mix = shortconv_mixer(u, sc_w_in[j], sc_conv_w[j], sc_w_out[j])
        h = h + mix.astype(h.dtype)
        u = rmsnorm(h, norm_ffn[i])
        h = h + conv_ffn(u, ffn_w_up[i], ffn_conv_w[i], ffn_conv_b[i], ffn_w_down[i]).astype(h.dtype)
    return rmsnorm(h, norm_final)
```

```cpp
#include <hip/hip_runtime.h>
#include <hip/hip_cooperative_groups.h>
#include <cstdio>
namespace cg = cooperative_groups;

#define LAS __attribute__((address_space(3)))
typedef unsigned short bf16_t;
typedef short bf16x8 __attribute__((ext_vector_type(8)));
typedef float f32x4 __attribute__((ext_vector_type(4)));
typedef float f32x2 __attribute__((ext_vector_type(2)));
typedef unsigned u32x4 __attribute__((ext_vector_type(4)));
typedef unsigned u32x2 __attribute__((ext_vector_type(2)));

constexpr int MTOK = 32768, DM = 1024, DFF = 2816, NG = 64, NP = 64, NROW = 2048  , KA = 384  ;
constexpr float RMS_EPS = 1e-6f;

constexpr size_t WS_CTL   = 0;
constexpr size_t WS_SSQ   = 16384;
constexpr size_t WS_WGLU  = WS_SSQ + 4ull * MTOK * 4;
constexpr size_t WS_WUP0  = WS_WGLU + 2048ull * 1024 * 2;
constexpr size_t WS_WUP1  = WS_WUP0 + 5632ull * 1024 * 2;
constexpr size_t WS_WDN0  = WS_WUP1 + 5632ull * 1024 * 2;
constexpr size_t WS_WDN1  = WS_WDN0 + 1024ull * 2816 * 2;
constexpr size_t WS_WIN   = WS_WDN1 + 1024ull * 2816 * 2;
constexpr size_t WS_WOUT  = WS_WIN + 4096ull * 1024 * 2;
constexpr size_t WS_BTA   = WS_WOUT + 1024ull * 1024 * 2;
constexpr size_t WS_BTB   = WS_BTA + 64ull * 256 * 256 * 2;
constexpr size_t WS_Z     = WS_BTB + 64ull * 256 * 384 * 2;
constexpr size_t WS_HB    = WS_Z + (size_t)MTOK * 1024 * 2;
constexpr size_t WS_HALO  = WS_HB + (size_t)MTOK * 1024 * 2;
constexpr size_t WS_R1    = WS_HALO + 512ull * 6 * 2816 * 4;
constexpr size_t WS_AP    = WS_R1;
constexpr size_t WS_S     = WS_AP + 64ull * 2048 * 384 * 2;
constexpr size_t WS_ACT   = WS_R1;
constexpr size_t WS_R1_SZ = (64ull * 2048 * 384 * 2 + 64ull * 2048 * 128 * 4) > ((size_t)MTOK * 2816 * 2) ? (64ull * 2048 * 384 * 2 + 64ull * 2048 * 128 * 4) : ((size_t)MTOK * 2816 * 2);
constexpr size_t WS_END   = WS_R1 + WS_R1_SZ;

__device__ __forceinline__ unsigned cvt_pk_bf16(float lo, float hi) { unsigned r; asm volatile("v_cvt_pk_bf16_f32 %0, %1, %2" : "=v"(r) : "v"(lo), "v"(hi)); return r; }
__device__ __forceinline__ float bf_lo(unsigned w) { return __uint_as_float(w << 16); }
__device__ __forceinline__ float bf_hi(unsigned w) { return __uint_as_float(w & 0xffff0000u); }
__device__ __forceinline__ float fast_sigmoid(float x) { return __builtin_amdgcn_rcpf(1.0f + __builtin_amdgcn_exp2f(x * -1.44269504f)); }
__device__ __forceinline__ float gelu_tanh(float y) { const float t = y * (-2.302208198f + -0.1029432397f * (y * y)); return y * __builtin_amdgcn_rcpf(1.0f + __builtin_amdgcn_exp2f(t)); }
__device__ __forceinline__ float silu_f(float x) { return x * __builtin_amdgcn_rcpf(1.0f + __builtin_amdgcn_exp2f(x * -1.44269504f)); }
template <int CTRL> __device__ __forceinline__ float dpp_mov(float old, float x) { return __int_as_float(__builtin_amdgcn_update_dpp(__float_as_int(old), __float_as_int(x), CTRL, 0xf, 0xf, false)); }
__device__ __forceinline__ int otid() { int t = threadIdx.x; asm volatile("" : "+v"(t)); return t; }
#define XB_XCNT(j)  (256  + 64 * (j))
#define XB_XSUB(j)  (1280 + 64 * (j))
#define XB_XGEN(j)  (2304 + 64 * (j))
#define XB_TOP      3328
#define XB_TOPGEN   3392
#define XCD_BAR_WORDS 3456
__device__ __forceinline__ unsigned xb_ld(unsigned* p)              { return __hip_atomic_load(p, __ATOMIC_RELAXED, __HIP_MEMORY_SCOPE_AGENT); }
__device__ __forceinline__ unsigned xb_add(unsigned* p, unsigned v) { return __hip_atomic_fetch_add(p, v, __ATOMIC_RELAXED, __HIP_MEMORY_SCOPE_AGENT); }
__device__ __forceinline__ unsigned xb_xcc_id() { return (unsigned)__builtin_amdgcn_s_getreg((3 << 11) | 20) & 0xFu; }
__device__ __forceinline__ void xb_complete(unsigned* bar, unsigned x, unsigned& nloc, unsigned& nx) {
    const unsigned G = gridDim.x; unsigned sum, cnt, mine;
    for (;;) { sum = 0u; cnt = 0u; mine = 0u;
#pragma unroll
        for (unsigned j = 0; j < 16; ++j) { const unsigned c = xb_ld(&bar[XB_XCNT(j)]); sum += c; cnt += (c > 0u) ? 1u : 0u; mine = (j == x) ? c : mine; }
        if (sum == G) break;
        __builtin_amdgcn_s_sleep(1); }
    nloc = mine > 0u ? mine : 1u; nx = cnt > 0u ? cnt : 1u;
}
__device__ __forceinline__ void grid_bar(unsigned* bar, unsigned x, volatile LAS unsigned* st) {
    asm volatile("s_waitcnt vmcnt(0) lgkmcnt(0)" ::: "memory");
    __syncthreads();
    if (threadIdx.x == 0) {
        __builtin_amdgcn_s_waitcnt(0);
        unsigned nloc = st[0], nx = st[1];
        if (nloc == 0u) { xb_complete(bar, x, nloc, nx); st[0] = nloc; st[1] = nx; }
        const unsigned old = xb_add(&bar[XB_XSUB(x)], 1u);
        const unsigned gen = old / nloc;
        if (old + 1u == (gen + 1u) * nloc) {
            __builtin_amdgcn_fence(__ATOMIC_RELEASE, "agent");
            asm volatile("s_waitcnt vmcnt(0)" ::: "memory");
            const unsigned og = xb_add(&bar[XB_TOP], 1u);
            const unsigned tg = og / nx;
            if (og + 1u == (tg + 1u) * nx) xb_add(&bar[XB_TOPGEN], 1u);
            else while (xb_ld(&bar[XB_TOPGEN]) == tg) __builtin_amdgcn_s_sleep(1);
            __builtin_amdgcn_fence(__ATOMIC_ACQUIRE, "agent");
            xb_add(&bar[XB_XGEN(x)], 1u);
            asm volatile("s_waitcnt vmcnt(0)" ::: "memory");
        } else {
            while (xb_ld(&bar[XB_XGEN(x)]) == gen) __builtin_amdgcn_s_sleep(1);
            __builtin_amdgcn_fence(__ATOMIC_ACQUIRE, "agent");
            asm volatile("s_waitcnt vmcnt(0)" ::: "memory");
        }
    }
    __syncthreads();
}

constexpr int BM = 256, BK = 64, HALF = 128, HTB = HALF * BK * 2, STAGE_BYTES = 8 * HTB, NXCD = 8, WGM = 8;
__device__ __forceinline__ int lds_byte(int r, int c) { const int st = (r >> 4) * 2 + (c >> 5), rr = r & 15, cc = c & 31, ob = rr * 64 + cc * 2; return st * 1024 + (ob ^ (((ob >> 9) & 1) << 5)); }
__device__ __forceinline__ void stage_rc(int b, int& R, int& C) { const int st = b / 1024, sb = b % 1024, swz = sb ^ (((sb >> 9) & 1) << 5); R = (st >> 1) * 16 + swz / 64; C = (st & 1) * 32 + (swz % 64) / 2; }

struct Unit { int pm, pn, g; };
struct StdOrder {
    int nM, nN, nwg, G, c; size_t atile, btile;
    __device__ __forceinline__ void init(int M, int N, int lda, int K) { nM = M / BM; nN = N / BM; nwg = nM * nN; G = gridDim.x; c = blockIdx.x; asm volatile("" : "+s"(c), "+s"(nN));     atile = (size_t)BM * lda * 2; btile = (size_t)BM * K * 2; }
    __device__ __forceinline__ bool next(int i, Unit& u) const {
        const long L = (long)i * G + c; if (L >= nwg) return false;
        int wgid = (int)L; { const int q = nwg / NXCD, r = nwg % NXCD, xcd = wgid % NXCD, off = wgid / NXCD; wgid = (xcd < r ? xcd * (q + 1) : r * (q + 1) + (xcd - r) * q) + off; }
        const int nig = WGM * nN, gid = wgid / nig, fm = gid * WGM, gsz = (nM - fm) < WGM ? (nM - fm) : WGM;
        u.pm = __builtin_amdgcn_readfirstlane(fm + ((wgid % nig) % gsz)); u.pn = __builtin_amdgcn_readfirstlane((wgid % nig) / gsz); u.g = 0; return true;
    }
    __device__ __forceinline__ size_t a_off(const Unit& u) const { return (size_t)u.pm * atile; }
    __device__ __forceinline__ size_t b_off(const Unit& u) const { return (size_t)u.pn * btile; }
};
struct S5Order {
    int G, c; size_t btile;
    __device__ __forceinline__ void init(int K) { G = gridDim.x; c = blockIdx.x; asm volatile("" : "+s"(c)); btile = (size_t)BM * K * 2; }
    __device__ __forceinline__ bool next(int i, Unit& u) const { const long L = (long)i * G + c; if (L >= NG * 8) return false; u.g = (int)(L >> 3); u.pm = (int)(L & 7); u.pn = 0; return true; }
    __device__ __forceinline__ size_t a_off(const Unit& u) const { return ((size_t)u.g * NROW + (size_t)u.pm * BM) * KA * 2; }
    __device__ __forceinline__ size_t b_off(const Unit& u) const { return (size_t)u.g * btile; }
};

struct S5PairOrder {
    int g, b; size_t btile;
    __device__ __forceinline__ void init(int it, int K) { g = it >> 2; b = it & 3; btile = (size_t)BM * K * 2; }
    __device__ __forceinline__ bool next(int i, Unit& u) const { if (i >= 2) return false; u.g = g; u.pm = 2 * b + i; u.pn = 0; return true; }
    __device__ __forceinline__ size_t a_off(const Unit& u) const { return ((size_t)u.g * NROW + (size_t)u.pm * BM) * KA * 2; }
    __device__ __forceinline__ size_t b_off(const Unit& u) const { return (size_t)u.g * btile; }
};

template <int NB1 = 2, class Epi, class Sched>
__device__ __forceinline__ void gemm_phase(LAS unsigned char* lds, const bf16_t* Ap, int lda, const bf16_t* Btp, int K, const Sched& S, const Epi& E) {
    int tid_ = threadIdx.x; asm volatile("" : "+v"(tid_));
    const int tid = tid_, wid = __builtin_amdgcn_readfirstlane(tid >> 6), lane = tid & 63, wr = wid >> 2, wc = wid & 3, fr = lane & 15, fq = lane >> 4;
    asm volatile("" : "+s"(K), "+s"(lda));
    const int nt = K / BK;
    unsigned voffA[2], voffB[2];
#pragma unroll
    for (int i = 0; i < 2; ++i) { int R, C; stage_rc(tid * 16 + i * 8192, R, C); voffA[i] = (unsigned)(R * lda + C) * 2u; voffB[i] = (unsigned)(R * K + C) * 2u; }
    const size_t kstep = (size_t)(BK * 2);
    const size_t hstepA = (size_t)HALF * lda * 2, hstepB = (size_t)HALF * K * 2;
    const unsigned ldsw = (unsigned)wid * 1024u;
    const int aoff = lds_byte(wr * 64 + fr, fq * 8), boff = lds_byte(wc * 32 + fr, fq * 8);
#define PG8_SA(b, h) (((b) * 2 + (h)) * HTB)
#define PG8_SB(b, h) ((4 + (b) * 2 + (h)) * HTB)
#define PG8_STAGE(bufoff, gbase, voff) do { const __amdgpu_buffer_rsrc_t _r = __builtin_amdgcn_make_buffer_rsrc((void*)(gbase), (short)0, 0x7fffffff, 0x00020000); _Pragma("unroll") for (int _i = 0; _i < 2; ++_i) \
        __builtin_amdgcn_raw_ptr_buffer_load_lds(_r, (LAS unsigned*)(lds + (bufoff) + ldsw + _i * 8192), 16, (int)(voff)[_i], 0, 0, 0); } while (0)
#define PG8_LDA(dst, b, h) do { _Pragma("unroll") for (int m = 0; m < 4; ++m) _Pragma("unroll") for (int k = 0; k < 2; ++k) dst[m][k] = *(const LAS bf16x8*)(lds + PG8_SA(b, h) + aoff + m * 2048 + k * 1024); } while (0)
#define PG8_LDB(dst, b, h) do { _Pragma("unroll") for (int n = 0; n < 2; ++n) _Pragma("unroll") for (int k = 0; k < 2; ++k) dst[n][k] = *(const LAS bf16x8*)(lds + PG8_SB(b, h) + boff + n * 2048 + k * 1024); } while (0)
#define PG8_MMA(ai, bj, At, Bt) do { __builtin_amdgcn_s_setprio(1); _Pragma("unroll") for (int k = 0; k < 2; ++k) _Pragma("unroll") for (int m = 0; m < 4; ++m) _Pragma("unroll") for (int n = 0; n < ((bj) == 1 ? NB1 : 2); ++n) \
        acc[ai][bj][m][n] = __builtin_amdgcn_mfma_f32_16x16x32_bf16(Bt[n][k], At[m][k], acc[ai][bj][m][n], 0, 0, 0); __builtin_amdgcn_s_setprio(0); } while (0)
#define PG8_WAIT_V(n) asm volatile("s_waitcnt vmcnt(" #n ")" ::: "memory")
#define PG8_WAIT_L(n) asm volatile("s_waitcnt lgkmcnt(" #n ")" ::: "memory")
#define PG8_BAR __builtin_amdgcn_s_barrier()
#define PG8_SCHED __builtin_amdgcn_sched_barrier(0)
    Unit cur, nxt; int ui = 0;
    if (!S.next(0, cur)) return;
    f32x4 epar = E.prefetch(cur, wr, wc, lane);
    f32x4 acc[2][2][4][2];
#pragma unroll
    for (int a = 0; a < 2; ++a)
#pragma unroll
        for (int b = 0; b < 2; ++b)
#pragma unroll
            for (int m = 0; m < 4; ++m)
#pragma unroll
                for (int n = 0; n < 2; ++n) acc[a][b][m][n] = (f32x4){0.f, 0.f, 0.f, 0.f};
    bf16x8 At[4][2], B0[2][2], B1[2][2];
    const char* cA = (const char*)Ap + S.a_off(cur); const char* cB = (const char*)Btp + S.b_off(cur);
    PG8_STAGE(PG8_SB(0, 0), cB, voffB); PG8_STAGE(PG8_SA(0, 0), cA, voffA); PG8_STAGE(PG8_SB(0, 1), cB + hstepB, voffB); PG8_STAGE(PG8_SA(0, 1), cA + hstepA, voffA);
    if (wr == 1) PG8_BAR;
    PG8_WAIT_V(4); PG8_BAR;
    PG8_STAGE(PG8_SB(1, 0), cB + kstep, voffB); PG8_STAGE(PG8_SA(1, 0), cA + kstep, voffA); PG8_STAGE(PG8_SB(1, 1), cB + hstepB + kstep, voffB);
    PG8_WAIT_V(6); PG8_BAR;
    for (;;) {
        const bool has_next = S.next(ui + 1, nxt);
        const char* nA = has_next ? (const char*)Ap + S.a_off(nxt) : cA; const char* nB = has_next ? (const char*)Btp + S.b_off(nxt) : cB;
        for (int t = 0; t < nt; t += 2) {
            const bool last = (t == nt - 2);
            const char* a1 = cA + (size_t)(t + 1) * kstep;
            const char* a2 = last ? nA : cA + (size_t)(t + 2) * kstep; const char* b2 = last ? nB : cB + (size_t)(t + 2) * kstep;
            const char* a3 = a2 + kstep; const char* b3 = b2 + kstep;
            PG8_LDB(B0, 0, 0); PG8_SCHED; PG8_LDA(At, 0, 0); PG8_STAGE(PG8_SA(1, 1), a1 + hstepA, voffA);
            PG8_WAIT_L(8); PG8_BAR; PG8_WAIT_L(0); PG8_MMA(0, 0, At, B0); PG8_BAR; PG8_SCHED;
            PG8_LDB(B1, 0, 1); PG8_STAGE(PG8_SB(0, 0), b2, voffB);
            PG8_BAR; PG8_WAIT_L(0); PG8_MMA(0, 1, At, B1); PG8_BAR;
            PG8_LDA(At, 0, 1); PG8_STAGE(PG8_SA(0, 0), a2, voffA);
            PG8_BAR; PG8_WAIT_L(0); PG8_MMA(1, 0, At, B0); PG8_BAR; PG8_SCHED;
            PG8_STAGE(PG8_SB(0, 1), b2 + hstepB, voffB);
            PG8_WAIT_V(6); PG8_BAR; PG8_MMA(1, 1, At, B1); PG8_BAR;
            PG8_LDB(B0, 1, 0); PG8_SCHED; PG8_LDA(At, 1, 0); PG8_STAGE(PG8_SA(0, 1), a2 + hstepA, voffA);
            PG8_WAIT_L(8); PG8_BAR; PG8_WAIT_L(0); PG8_MMA(0, 0, At, B0); PG8_BAR; PG8_SCHED;
            PG8_LDB(B1, 1, 1); PG8_STAGE(PG8_SB(1, 0), b3, voffB);
            PG8_BAR; PG8_WAIT_L(0); PG8_MMA(0, 1, At, B1); PG8_BAR;
            PG8_LDA(At, 1, 1); PG8_STAGE(PG8_SA(1, 0), a3, voffA);
            PG8_BAR; PG8_WAIT_L(0); PG8_MMA(1, 0, At, B0); PG8_BAR; PG8_SCHED;
            PG8_STAGE(PG8_SB(1, 1), b3 + hstepB, voffB);
            PG8_WAIT_V(6); PG8_BAR; PG8_MMA(1, 1, At, B1); PG8_BAR;
        }
        E(acc, cur, wr, wc, fr, fq, lds, epar);
        if (has_next) epar = E.prefetch(nxt, wr, wc, lane);
        if (!has_next) break;
#pragma unroll
        for (int a = 0; a < 2; ++a)
#pragma unroll
            for (int b = 0; b < 2; ++b)
#pragma unroll
                for (int m = 0; m < 4; ++m)
#pragma unroll
                    for (int n = 0; n < 2; ++n) acc[a][b][m][n] = (f32x4){0.f, 0.f, 0.f, 0.f};
        cur = nxt; cA = nA; cB = nB; ++ui;
    }
    PG8_WAIT_V(0);
    if (wr == 0) PG8_BAR;
    PG8_BAR;
#undef PG8_SA
#undef PG8_SB
#undef PG8_STAGE
#undef PG8_LDA
#undef PG8_LDB
#undef PG8_MMA
#undef PG8_WAIT_V
#undef PG8_WAIT_L
#undef PG8_BAR
#undef PG8_SCHED
}

typedef f32x4 Acc[2][2][4][2];

struct EpiS5a {
    __device__ __forceinline__ f32x4 prefetch(const Unit&, int, int, int) const { return (f32x4){0.f, 0.f, 0.f, 0.f}; }
    float* S;
    __device__ __forceinline__ void operator()(const Acc& acc, const Unit& u, int wr, int wc, int fr, int fq, LAS unsigned char* lds, f32x4 epar) const {
        const int row0 = u.g * NROW + u.pm * BM + wr * 64 + fr, col0 = wc * 32 + 4 * fq;
#pragma unroll
        for (int ai = 0; ai < 2; ++ai)
#pragma unroll
            for (int m = 0; m < 4; ++m) { float* rowp = S + (size_t)(row0 + ai * HALF + m * 16) * 128 + col0;
#pragma unroll
                for (int n = 0; n < 2; ++n) *(f32x4*)(rowp + n * 16) = acc[ai][0][m][n]; }
    }
};
struct EpiS5b {
    __device__ __forceinline__ f32x4 prefetch(const Unit&, int, int, int) const { return (f32x4){0.f, 0.f, 0.f, 0.f}; }
    const bf16_t* AP; const float* dskip; bf16_t* Z;
    __device__ __forceinline__ void operator()(const Acc& acc, const Unit& u, int wr, int wc, int fr, int fq, LAS unsigned char* lds, f32x4 epar) const {
        const int h0 = 8 * (fq & 1);
        const f32x4 d0 = *(const f32x4*)(dskip + u.g * 16 + h0), d1 = *(const f32x4*)(dskip + u.g * 16 + h0 + 4);
        u32x4 uu[2][4][2];
#pragma unroll
        for (int ai = 0; ai < 2; ++ai)
#pragma unroll
            for (int m = 0; m < 4; ++m) { const int Rg = u.pm * BM + ai * HALF + wr * 64 + m * 16 + fr;
#pragma unroll
                for (int bj = 0; bj < 2; ++bj) { const int t = 8 * bj + 2 * wc + (fq >> 1); uu[ai][m][bj] = *(const u32x4*)(AP + ((size_t)u.g * NROW + Rg) * KA + t * 16 + h0); } }
#pragma unroll
        for (int ai = 0; ai < 2; ++ai)
#pragma unroll
            for (int m = 0; m < 4; ++m) { const int Rg = u.pm * BM + ai * HALF + wr * 64 + m * 16 + fr;
#pragma unroll
                for (int bj = 0; bj < 2; ++bj) { const int t = 8 * bj + 2 * wc + (fq >> 1);
                    const u32x4 q = uu[ai][m][bj];
                    const f32x4 a0 = acc[ai][bj][m][0], a1 = acc[ai][bj][m][1];
                    float y[8];
                    y[0] = a0[0] + d0[0] * bf_lo(q.x); y[1] = a0[1] + d0[1] * bf_hi(q.x); y[2] = a0[2] + d0[2] * bf_lo(q.y); y[3] = a0[3] + d0[3] * bf_hi(q.y);
                    y[4] = a1[0] + d1[0] * bf_lo(q.z); y[5] = a1[1] + d1[1] * bf_hi(q.z); y[6] = a1[2] + d1[2] * bf_lo(q.w); y[7] = a1[3] + d1[3] * bf_hi(q.w);
#pragma unroll
                    for (int i = 0; i < 8; ++i) y[i] = gelu_tanh(y[i]);
                    u32x4 w; w.x = cvt_pk_bf16(y[0], y[1]); w.y = cvt_pk_bf16(y[2], y[3]); w.z = cvt_pk_bf16(y[4], y[5]); w.w = cvt_pk_bf16(y[6], y[7]);
                    *(u32x4*)(Z + ((size_t)Rg * 16 + t) * DM + u.g * 16 + h0) = w; } }
    }
};
struct EpiGlu {
    __device__ __forceinline__ f32x4 prefetch(const Unit&, int, int, int) const { return (f32x4){0.f, 0.f, 0.f, 0.f}; }
    const float* x; bf16_t* HB; float* ssq;
    __device__ __forceinline__ void operator()(const Acc& acc, const Unit& u, int wr, int wc, int fr, int fq, LAS unsigned char* lds, f32x4 epar) const {
        const int c0 = u.pn * 128 + wc * 32 + 8 * fq;
        f32x4 xv[2][4][2];
#pragma unroll
        for (int ai = 0; ai < 2; ++ai)
#pragma unroll
            for (int m = 0; m < 4; ++m) { const int r = u.pm * BM + ai * HALF + wr * 64 + m * 16 + fr; const size_t off = (size_t)r * DM + c0;
                xv[ai][m][0] = __builtin_nontemporal_load((const f32x4*)(x + off)); xv[ai][m][1] = __builtin_nontemporal_load((const f32x4*)(x + off + 4)); }
#pragma unroll
        for (int ai = 0; ai < 2; ++ai)
#pragma unroll
            for (int m = 0; m < 4; ++m) { const int r = u.pm * BM + ai * HALF + wr * 64 + m * 16 + fr; const size_t off = (size_t)r * DM + c0;
                f32x4 v0 = xv[ai][m][0], v1 = xv[ai][m][1];
                const f32x4 za0 = acc[ai][0][m][0], za1 = acc[ai][0][m][1], zg0 = acc[ai][1][m][0], zg1 = acc[ai][1][m][1];
#pragma unroll
                for (int j = 0; j < 4; ++j) { v0[j] += za0[j] * fast_sigmoid(zg0[j]); v1[j] += za1[j] * fast_sigmoid(zg1[j]); }
                u32x4 w; w.x = cvt_pk_bf16(v0[0], v0[1]); w.y = cvt_pk_bf16(v0[2], v0[3]); w.z = cvt_pk_bf16(v1[0], v1[1]); w.w = cvt_pk_bf16(v1[2], v1[3]);
                *(u32x4*)(HB + off) = w;
                float s = (v0[0] * v0[0] + v0[1] * v0[1]) + (v0[2] * v0[2] + v0[3] * v0[3]) + (v1[0] * v1[0] + v1[1] * v1[1]) + (v1[2] * v1[2] + v1[3] * v1[3]);
                s += __shfl_xor(s, 16); s += __shfl_xor(s, 32);
                if (fq == 0) unsafeAtomicAdd(ssq + r, s); }
    }
};
template <bool LAST> struct EpiRes {
    __device__ __forceinline__ f32x4 prefetch(const Unit&, int, int, int) const { return (f32x4){0.f, 0.f, 0.f, 0.f}; }
    bf16_t* HB; float* ssq;
    __device__ __forceinline__ void operator()(const Acc& acc, const Unit& u, int wr, int wc, int fr, int fq, LAS unsigned char* lds, f32x4 epar) const {
        u32x4 hv[2][4][2];
#pragma unroll
        for (int ai = 0; ai < 2; ++ai)
#pragma unroll
            for (int m = 0; m < 4; ++m) { const int r = u.pm * BM + ai * HALF + wr * 64 + m * 16 + fr;
#pragma unroll
                for (int bj = 0; bj < 2; ++bj) hv[ai][m][bj] = *(const u32x4*)(HB + (size_t)r * DM + u.pn * 256 + bj * 128 + wc * 32 + 8 * fq); }
#pragma unroll
        for (int ai = 0; ai < 2; ++ai)
#pragma unroll
            for (int m = 0; m < 4; ++m) { const int r = u.pm * BM + ai * HALF + wr * 64 + m * 16 + fr; float s = 0.f;
#pragma unroll
                for (int bj = 0; bj < 2; ++bj) { const size_t off = (size_t)r * DM + u.pn * 256 + bj * 128 + wc * 32 + 8 * fq;
                    const u32x4 q = hv[ai][m][bj];
                    f32x4 v0 = (f32x4){bf_lo(q.x), bf_hi(q.x), bf_lo(q.y), bf_hi(q.y)}, v1 = (f32x4){bf_lo(q.z), bf_hi(q.z), bf_lo(q.w), bf_hi(q.w)};
                    v0 += acc[ai][bj][m][0]; v1 += acc[ai][bj][m][1];
                    u32x4 w; w.x = cvt_pk_bf16(v0[0], v0[1]); w.y = cvt_pk_bf16(v0[2], v0[3]); w.z = cvt_pk_bf16(v1[0], v1[1]); w.w = cvt_pk_bf16(v1[2], v1[3]);
                    *(u32x4*)(HB + off) = w;
                    s += (v0[0] * v0[0] + v0[1] * v0[1]) + (v0[2] * v0[2] + v0[3] * v0[3]) + (v1[0] * v1[0] + v1[1] * v1[1]) + (v1[2] * v1[2] + v1[3] * v1[3]); }
                s += __shfl_xor(s, 16); s += __shfl_xor(s, 32);
                if (fq == 0) unsafeAtomicAdd(ssq + r, s); }
    }
};
template <int MODE> struct EpiConv {
    const float* ssq; const float* cw; const float* cb; bf16_t* out; float* halo; int C;
    __device__ __forceinline__ f32x4 prefetch(const Unit& u, int wr, int wc, int lane) const {
        const float* ptr;
        if (lane < 32) { const int arr = lane >> 3, j = lane & 7;
            if (MODE == 0) ptr = (arr < 3 ? cw + arr * C : cb) + u.pn * 128 + wc * 32 + 4 * j;
            else ptr = cw + (arr < 3 ? arr : 0) * C + u.pn * 64 + wc * 16 + 4 * (j & 3); }
        else { const int k = lane - 32; ptr = ssq + u.pm * BM + (k >> 4) * HALF + wr * 64 + 4 * (k & 15); }
        f32x4 v; asm volatile("global_load_dwordx4 %0, %1, off" : "=&v"(v) : "v"(ptr) : "memory"); return v;
    }
    __device__ __forceinline__ void operator()(const Acc& acc, const Unit& u, int wr, int wc, int fr, int fq, LAS unsigned char* lds, f32x4 epar) const {
        constexpr int NV = MODE == 0 ? 8 : 4;
        const int c0 = MODE == 0 ? (u.pn * 128 + wc * 32 + 8 * fq) : (u.pn * 64 + wc * 16 + 4 * fq);
        LAS float* pw = (LAS float*)(lds + STAGE_BYTES + 64 + (wr * 4 + wc) * 1024);
        *(LAS f32x4*)(pw + (fq * 16 + fr) * 4) = epar;
        asm volatile("s_waitcnt lgkmcnt(0)" ::: "memory");
        float w0[NV], w1[NV], w2[NV], bb[NV];
#pragma unroll
        for (int i = 0; i < NV; i += 4) { const f32x4 a = *(const LAS f32x4*)(pw + NV * fq + i), b = *(const LAS f32x4*)(pw + 32 + NV * fq + i), c = *(const LAS f32x4*)(pw + 64 + NV * fq + i);
            f32x4 d = (f32x4){0.f, 0.f, 0.f, 0.f}; if (MODE == 0) d = *(const LAS f32x4*)(pw + 96 + NV * fq + i);
#pragma unroll
            for (int j = 0; j < 4; ++j) { w0[i + j] = a[j]; w1[i + j] = b[j]; w2[i + j] = c[j]; bb[i + j] = d[j]; } }
        float sq[2][4];
#pragma unroll
        for (int ai = 0; ai < 2; ++ai)
#pragma unroll
            for (int m = 0; m < 4; ++m) sq[ai][m] = pw[128 + ai * 64 + m * 16 + fr];
#pragma unroll
        for (int ai = 0; ai < 2; ++ai) {
            const int strip = u.pm * 4 + ai * 2 + wr;
            float p1prev[NV], p2prev[NV];
#pragma unroll
            for (int i = 0; i < NV; ++i) { p1prev[i] = 0.f; p2prev[i] = 0.f; }
#pragma unroll
            for (int m = 0; m < 4; ++m) {
                const int r = u.pm * BM + ai * HALF + wr * 64 + m * 16 + fr;
                const float rs = __builtin_amdgcn_rsqf(sq[ai][m] * (1.0f / DM) + RMS_EPS);
                float X[NV], Y[NV], o[NV];
                if (MODE == 0) {
#pragma unroll
                    for (int n = 0; n < 2; ++n)
#pragma unroll
                        for (int j = 0; j < 4; ++j) { X[n * 4 + j] = acc[ai][0][m][n][j] * rs; Y[n * 4 + j] = acc[ai][1][m][n][j] * rs; }
                } else {
#pragma unroll
                    for (int j = 0; j < 4; ++j) { X[j] = (acc[ai][0][m][1][j] * rs) * (acc[ai][1][m][0][j] * rs); Y[j] = acc[ai][0][m][0][j] * rs; }
                }
#pragma unroll
                for (int i = 0; i < NV; ++i) {
                    const float q1 = dpp_mov<0x111>(p1prev[i], X[i]), q2 = dpp_mov<0x112>(p2prev[i], X[i]);
                    p1prev[i] = dpp_mov<0x121>(0.f, X[i]); p2prev[i] = dpp_mov<0x122>(0.f, X[i]);
                    const float cv = w2[i] * X[i] + w1[i] * q1 + w0[i] * q2 + bb[i];
                    o[i] = MODE == 0 ? silu_f(cv) * Y[i] : cv * Y[i];
                }
                if (m == 0 && fr < 2) {
                    float* hx = halo + ((size_t)strip * 6 + 2 + fr) * C + c0; float* hy = halo + ((size_t)strip * 6 + 4 + fr) * C + c0;
#pragma unroll
                    for (int i = 0; i < NV; i += 4) { *(f32x4*)(hx + i) = (f32x4){X[i], X[i + 1], X[i + 2], X[i + 3]}; *(f32x4*)(hy + i) = (f32x4){Y[i], Y[i + 1], Y[i + 2], Y[i + 3]}; }
                } else {
                    if (MODE == 0) { u32x4 w; w.x = cvt_pk_bf16(o[0], o[1]); w.y = cvt_pk_bf16(o[2], o[3]); w.z = cvt_pk_bf16(o[4 % NV], o[5 % NV]); w.w = cvt_pk_bf16(o[6 % NV], o[7 % NV]);
                        __builtin_nontemporal_store(w, (u32x4*)(out + (size_t)r * C + c0)); }
                    else { u32x2 w; w.x = cvt_pk_bf16(o[0], o[1]); w.y = cvt_pk_bf16(o[2], o[3]); __builtin_nontemporal_store(w, (u32x2*)(out + (size_t)r * C + c0)); }
                }
                if (m == 3 && fr >= 14) { float* hx = halo + ((size_t)strip * 6 + (fr - 14)) * C + c0;
#pragma unroll
                    for (int i = 0; i < NV; i += 4) *(f32x4*)(hx + i) = (f32x4){X[i], X[i + 1], X[i + 2], X[i + 3]}; }
            }
        }
    }
};

struct Params {
    const float* x; const float* norm_mix; const float* norm_ffn; const float* norm_final;
    const float* a_re; const float* a_im; const float* log_dt; const float* b_re; const float* b_im; const float* c_re; const float* c_im; const float* s5_d;
    const float* w_glu; const float* w_in; const float* sc_conv; const float* w_out; const float* w_up; const float* ffn_conv_w; const float* ffn_conv_b; const float* w_down;
    float* out; unsigned char* ws;
};

__device__ __forceinline__ f32x2 cpow_n(float lr, float li, float dt, float n) {
    const float mag = __expf(lr * dt * n);
    double tr = (double)li * (double)dt * (double)n * 0.15915494309189535; tr -= rint(tr);
    const float ang = (float)(tr * 6.283185307179586);
    return (f32x2){mag * cosf(ang), mag * sinf(ang)};
}

__device__ __forceinline__ void s5_precompute(const Params& p, int g, LAS unsigned char* lds) {
    LAS f32x2* pw = (LAS f32x2*)lds;
    LAS f32x2* Bb = pw + 17 * 64;
    LAS f32x2* Cc = Bb + 64 * 16;
    LAS f32x2* Gg = Cc + 16 * 64;
    LAS float* Kt = (LAS float*)(Gg + 64);
    const int tid = otid();
    for (int e = tid; e < 17 * 64; e += 512) { const int d = e >> 6, pp = e & 63; pw[e] = cpow_n(p.a_re[g * 64 + pp], p.a_im[g * 64 + pp], expf(p.log_dt[g]), (float)d); }
    if (tid < 64) {
        const float lr = p.a_re[g * 64 + tid], li = p.a_im[g * 64 + tid], dt = expf(p.log_dt[g]);
        double tr = (double)li * (double)dt * 0.15915494309189535; tr -= rint(tr);
        const float th = (float)(tr * 6.283185307179586);
        const float sh = sinf(0.5f * th), cs = cosf(th), sn = sinf(th);
        const float nr = expm1f(lr * dt) * cs - 2.0f * sh * sh, ni = expf(lr * dt) * sn;
        const float den = lr * lr + li * li;
        Gg[tid] = (f32x2){(nr * lr + ni * li) / den, (ni * lr - nr * li) / den};
    }
    __syncthreads();
    for (int i = tid; i < 1024; i += 512) { const int pp = i >> 4; const f32x2 gg = Gg[pp];
        const float br = p.b_re[(size_t)g * 1024 + i], bi = p.b_im[(size_t)g * 1024 + i];
        Bb[i] = (f32x2){gg.x * br - gg.y * bi, gg.x * bi + gg.y * br};
        Cc[i] = (f32x2){p.c_re[(size_t)g * 1024 + i], p.c_im[(size_t)g * 1024 + i]}; }
    __syncthreads();
    for (int e = tid; e < 4096; e += 512) { const int d = e >> 8, h = (e >> 4) & 15, hp = e & 15; float s = 0.f;
        for (int pp = 0; pp < 64; ++pp) { const f32x2 c = Cc[h * 64 + pp], w = pw[d * 64 + pp], b = Bb[pp * 16 + hp];
            const float tr_ = w.x * b.x - w.y * b.y, ti_ = w.x * b.y + w.y * b.x; s += c.x * tr_ - c.y * ti_; }
        Kt[e] = s; }
    __syncthreads();
    bf16_t* BTA = (bf16_t*)(p.ws + WS_BTA) + (size_t)g * 256 * 256;
    bf16_t* BTB = (bf16_t*)(p.ws + WS_BTB) + (size_t)g * 256 * 384;
    for (int pc = tid; pc < 256 * 32; pc += 512) { const int n = pc >> 5, k0 = (pc & 31) * 8; float v[8];
        const int s = k0 >> 4, hp0 = k0 & 15;
#pragma unroll
        for (int i = 0; i < 8; ++i) { float val = 0.f;
            if (n < 128) { const int pp = n & 63; const f32x2 w = pw[(15 - s) * 64 + pp], b = Bb[pp * 16 + hp0 + i];
                val = n < 64 ? (w.x * b.x - w.y * b.y) : (w.x * b.y + w.y * b.x); }
            v[i] = val; }
        u32x4 w4; w4.x = cvt_pk_bf16(v[0], v[1]); w4.y = cvt_pk_bf16(v[2], v[3]); w4.z = cvt_pk_bf16(v[4], v[5]); w4.w = cvt_pk_bf16(v[6], v[7]);
        *(u32x4*)(BTA + (size_t)n * 256 + k0) = w4; }
    for (int pc = tid; pc < 256 * 48; pc += 512) { const int slot = pc / 48, k0 = (pc % 48) * 8; float v[8];
        const int bj = slot >> 7, wc = (slot >> 5) & 3, nn = (slot >> 4) & 1, fq = (slot >> 2) & 3, j = slot & 3;
        const int nout = 128 * bj + 32 * wc + 8 * fq + 4 * nn + j, t = nout >> 4, h = nout & 15;
        if (k0 < 256) { const int s = k0 >> 4, hp0 = k0 & 15;
#pragma unroll
            for (int i = 0; i < 8; ++i) v[i] = s <= t ? Kt[((t - s) * 16 + h) * 16 + hp0 + i] : 0.f;
        } else { const int kp0 = k0 - 256;
#pragma unroll
            for (int i = 0; i < 8; ++i) { const int kp = kp0 + i, pp = kp & 63; const f32x2 c = Cc[h * 64 + pp], w = pw[(t + 1) * 64 + pp];
                v[i] = kp < 64 ? (c.x * w.x - c.y * w.y) : -(c.x * w.y + c.y * w.x); } }
        u32x4 w4; w4.x = cvt_pk_bf16(v[0], v[1]); w4.y = cvt_pk_bf16(v[2], v[3]); w4.z = cvt_pk_bf16(v[4], v[5]); w4.w = cvt_pk_bf16(v[6], v[7]);
        *(u32x4*)(BTB + (size_t)slot * 384 + k0) = w4; }
    __syncthreads();
}

__device__ __forceinline__ int dest_row(int kind, int n, int NPART) {
    if (kind == 0) { const int part = n / NPART, c = n % NPART, pn = c >> 7, cc = c & 127, wc = cc >> 5, r = cc & 31, fq = r >> 3, nn = (r >> 2) & 1, j = r & 3; return pn * 256 + 128 * part + 32 * wc + 16 * nn + 4 * fq + j; }
    if (kind == 1) { const int q = n >> 10, c = n & 1023, pn = c >> 6, cc = c & 63, wc = cc >> 4, r = cc & 15, fq = r >> 2, j = r & 3; return pn * 256 + 128 * (q >> 1) + 32 * wc + 16 * (q & 1) + 4 * fq + j; }
    const int pn = n >> 8, cc = n & 255, bj = cc >> 7, r2 = cc & 127, wc = r2 >> 5, r = r2 & 31, fq = r >> 3, nn = (r >> 2) & 1, j = r & 3; return pn * 256 + 128 * bj + 32 * wc + 16 * nn + 4 * fq + j;
}
constexpr int PI_S5 = 64, PI_GLU = 16 * 8, PI_UP = 16 * 22, PI_DN = 44 * 4, PI_IN = 16 * 12, PI_OUT = 16 * 4;
constexpr int PO_GLU = PI_S5, PO_UP0 = PO_GLU + PI_GLU, PO_UP1 = PO_UP0 + PI_UP, PO_DN0 = PO_UP1 + PI_UP, PO_DN1 = PO_DN0 + PI_DN, PO_IN = PO_DN1 + PI_DN, PO_OUT = PO_IN + PI_IN, PO_NORM = PO_OUT + PI_OUT, PI_ALL = PO_NORM + NROW;
struct WDesc { const float* W; int K, N; bf16_t* Bt; const float* gain; int kind, NPART, kb, nb; };
__device__ __forceinline__ bool item_desc(const Params& p, int it, WDesc& d) {
    if (it >= PO_NORM) return false;
    if (it < PO_UP0) { const int j = it - PO_GLU; d = WDesc{p.w_glu, 1024, 2048, (bf16_t*)(p.ws + WS_WGLU), nullptr, 0, 1024, j / 8, j % 8}; }
    else if (it < PO_UP1) { const int j = it - PO_UP0; d = WDesc{p.w_up, 1024, 5632, (bf16_t*)(p.ws + WS_WUP0), p.norm_ffn, 0, 2816, j / 22, j % 22}; }
    else if (it < PO_DN0) { const int j = it - PO_UP1; d = WDesc{p.w_up + (size_t)1024 * 5632, 1024, 5632, (bf16_t*)(p.ws + WS_WUP1), p.norm_ffn + 1024, 0, 2816, j / 22, j % 22}; }
    else if (it < PO_DN1) { const int j = it - PO_DN0; d = WDesc{p.w_down, 2816, 1024, (bf16_t*)(p.ws + WS_WDN0), nullptr, 2, 0, j / 4, j % 4}; }
    else if (it < PO_IN) { const int j = it - PO_DN1; d = WDesc{p.w_down + (size_t)2816 * 1024, 2816, 1024, (bf16_t*)(p.ws + WS_WDN1), nullptr, 2, 0, j / 4, j % 4}; }
    else if (it < PO_OUT) { const int j = it - PO_IN; d = WDesc{p.w_in, 1024, 3072, (bf16_t*)(p.ws + WS_WIN), p.norm_mix + 1024, 1, 0, j / 12, j % 12}; }
    else { const int j = it - PO_OUT; d = WDesc{p.w_out, 1024, 1024, (bf16_t*)(p.ws + WS_WOUT), nullptr, 2, 0, j / 4, j % 4}; }
    return true;
}
__device__ __forceinline__ void item_load(const Params& p, int it, f32x4 (&v)[8]) {
    const int tid = otid(); WDesc d;
    if (item_desc(p, it, d)) {
#pragma unroll
        for (int i = 0; i < 8; ++i) { const int idx = tid + i * 512, row = idx >> 6, c4 = idx & 63;
            v[i] = __builtin_nontemporal_load((const f32x4*)(d.W + (size_t)(d.kb * 64 + row) * d.N + d.nb * 256 + c4 * 4)); }
    } else {
        const int R = it - PO_NORM, wid = tid >> 6, lane = tid & 63;
#pragma unroll
        for (int q = 0; q < 2; ++q)
#pragma unroll
            for (int i = 0; i < 4; ++i) v[q * 4 + i] = __builtin_nontemporal_load((const f32x4*)(p.x + ((size_t)R * 16 + wid * 2 + q) * DM + i * 256 + lane * 4));
    }
}
__device__ __forceinline__ void item_finish(const Params& p, int it, const f32x4 (&v)[8], LAS unsigned char* lds) {
    const int tid = otid(); WDesc d;
    if (item_desc(p, it, d)) {
        LAS float* tile = (LAS float*)lds;
#pragma unroll
        for (int i = 0; i < 8; ++i) { const int idx = tid + i * 512, row = idx >> 6, c4 = idx & 63; f32x4 x = v[i];
            if (d.gain) { const float gk = d.gain[d.kb * 64 + row]; x *= gk; }
            tile[row * 257 + c4 * 4 + 0] = x[0]; tile[row * 257 + c4 * 4 + 1] = x[1]; tile[row * 257 + c4 * 4 + 2] = x[2]; tile[row * 257 + c4 * 4 + 3] = x[3]; }
        __syncthreads();
#pragma unroll
        for (int i = 0; i < 4; ++i) { const int idx = tid + i * 512, col = idx >> 3, piece = idx & 7; float t[8];
#pragma unroll
            for (int k = 0; k < 8; ++k) t[k] = tile[(piece * 8 + k) * 257 + col];
            u32x4 w4; w4.x = cvt_pk_bf16(t[0], t[1]); w4.y = cvt_pk_bf16(t[2], t[3]); w4.z = cvt_pk_bf16(t[4], t[5]); w4.w = cvt_pk_bf16(t[6], t[7]);
            *(u32x4*)(d.Bt + (size_t)dest_row(d.kind, d.nb * 256 + col, d.NPART) * d.K + d.kb * 64 + piece * 8) = w4; }
        __syncthreads();
    } else {
        const int R = it - PO_NORM, wid = tid >> 6, lane = tid & 63; bf16_t* AP = (bf16_t*)(p.ws + WS_AP);
#pragma unroll
        for (int q = 0; q < 2; ++q) { const int s = wid * 2 + q; float ss = 0.f;
#pragma unroll
            for (int i = 0; i < 4; ++i) { const f32x4 x = v[q * 4 + i]; ss += (x[0] * x[0] + x[1] * x[1]) + (x[2] * x[2] + x[3] * x[3]); }
#pragma unroll
            for (int o = 32; o >= 1; o >>= 1) ss += __shfl_xor(ss, o);
            const float rs = rsqrtf(ss * (1.0f / DM) + RMS_EPS);
#pragma unroll
            for (int i = 0; i < 4; ++i) { const int c = i * 256 + lane * 4; const f32x4 gn = *(const f32x4*)(p.norm_mix + c); const f32x4 x = v[q * 4 + i];
                u32x2 w; w.x = cvt_pk_bf16(x[0] * rs * gn[0], x[1] * rs * gn[1]); w.y = cvt_pk_bf16(x[2] * rs * gn[2], x[3] * rs * gn[3]);
                *(u32x2*)(AP + ((size_t)(c >> 4) * NROW + R) * KA + s * 16 + (c & 15)) = w; } }
    }
}
__device__ __forceinline__ void run_items(const Params& p, int it0, int step, int end, LAS unsigned char* lds) {
    if (it0 >= end) return;
    f32x4 cur[8], nxt[8];
    item_load(p, it0, cur);
    for (int it = it0; it < end; it += step) {
        const bool more = it + step < end;
        if (more) item_load(p, it + step, nxt);
        item_finish(p, it, cur, lds);
        if (more) {
#pragma unroll
            for (int i = 0; i < 8; ++i) cur[i] = nxt[i]; }
    }
}

__device__ __forceinline__ void prep_phase(const Params& p, LAS unsigned char* lds) {
    const int G = gridDim.x, bid = blockIdx.x, tid = otid();
    { float* ssq = (float*)(p.ws + WS_SSQ); for (int i = bid * 512 + tid; i < 4 * MTOK; i += G * 512) ssq[i] = 0.f;
      bf16_t* WIN = (bf16_t*)(p.ws + WS_WIN);
      for (int i = bid * 512 + tid; i < 1024 * 128; i += G * 512) { const int zr = i >> 7, piece = i & 127;
          const int pn = zr >> 6, wc = (zr >> 4) & 3, rr = zr & 15; const int row = pn * 256 + 128 + 32 * wc + 16 + rr;
          *(u32x4*)(WIN + (size_t)row * 1024 + piece * 8) = (u32x4){0u, 0u, 0u, 0u}; } }
    int first = PI_S5;
    if (G > PI_S5) {
        if (bid < PI_S5) s5_precompute(p, bid, lds);
        else { const int e10 = PI_S5 + 13 * (G - PI_S5); run_items(p, PI_S5 + (bid - PI_S5), G - PI_S5, e10 < PI_ALL ? e10 : PI_ALL, lds); }
        first = PI_S5 + 13 * (G - PI_S5);
    } else for (int it = bid; it < PI_S5; it += G) s5_precompute(p, it, lds);
    run_items(p, first + bid, G, PI_ALL, lds);
}

__device__ __forceinline__ void scan_item(const Params& p, int g, int b, LAS unsigned char* lds) {
    LAS f32x2* E = (LAS f32x2*)lds;
    const int tid = otid(), pp = tid & 63, seg = __builtin_amdgcn_readfirstlane(tid >> 6);
    const float* S = (const float*)(p.ws + WS_S); bf16_t* AP = (bf16_t*)(p.ws + WS_AP);
    const float lr = p.a_re[g * 64 + pp], li = p.a_im[g * 64 + pp], dt = expf(p.log_dt[g]);
    f32x2 A16 = cpow_n(lr, li, dt, 16.f), A1k = cpow_n(lr, li, dt, 1024.f);
    const size_t row0 = (size_t)g * NROW + b * 512 + seg * 64;
    asm volatile("" : "+v"(A16), "+v"(A1k) :: "memory");
    const __amdgpu_buffer_rsrc_t rs = __builtin_amdgcn_make_buffer_rsrc((void*)(S + row0 * 128), (short)0, 0x7fffffff, 0x00020000);
    constexpr int NREG = 48;
    float sr[NREG], si[NREG], tr[64 - NREG], ti[64 - NREG];
#pragma unroll
    for (int c = 0; c < NREG; ++c) { sr[c] = __uint_as_float(__builtin_amdgcn_raw_buffer_load_b32(rs, pp * 4, c * 512, 0)); si[c] = __uint_as_float(__builtin_amdgcn_raw_buffer_load_b32(rs, pp * 4, c * 512 + 256, 0)); }
#pragma unroll
    for (int c = NREG; c < 64; ++c) { tr[c - NREG] = __uint_as_float(__builtin_amdgcn_raw_buffer_load_b32(rs, pp * 4, c * 512, 0)); ti[c - NREG] = __uint_as_float(__builtin_amdgcn_raw_buffer_load_b32(rs, pp * 4, c * 512 + 256, 0)); }
    float xr = 0.f, xi = 0.f;
#pragma unroll
    for (int c = 0; c < NREG; ++c) { const float nr = A16.x * xr - A16.y * xi + sr[c], ni = A16.x * xi + A16.y * xr + si[c]; xr = nr; xi = ni; }
#pragma unroll
    for (int c = NREG; c < 64; ++c) { const float nr = A16.x * xr - A16.y * xi + tr[c - NREG], ni = A16.x * xi + A16.y * xr + ti[c - NREG]; xr = nr; xi = ni; }
    E[seg * 64 + pp] = (f32x2){xr, xi};
    asm volatile("" ::: "memory");
#pragma unroll
    for (int c = NREG; c < 64; ++c) { tr[c - NREG] = __uint_as_float(__builtin_amdgcn_raw_buffer_load_b32(rs, pp * 4, c * 512, 0)); ti[c - NREG] = __uint_as_float(__builtin_amdgcn_raw_buffer_load_b32(rs, pp * 4, c * 512 + 256, 0)); }
    __syncthreads();
    xr = 0.f; xi = 0.f;
    for (int j = 0; j < seg; ++j) { const f32x2 e = E[j * 64 + pp]; const float nr = A1k.x * xr - A1k.y * xi + e.x, ni = A1k.x * xi + A1k.y * xr + e.y; xr = nr; xi = ni; }
    const __amdgpu_buffer_rsrc_t rd = __builtin_amdgcn_make_buffer_rsrc((void*)(AP + row0 * KA + 256), (short)0, 0x7fffffff, 0x00020000);
#pragma unroll
    for (int c = 0; c < 64; ++c) {
        __builtin_amdgcn_raw_buffer_store_b16((short)(cvt_pk_bf16(xr, xr) & 0xffffu), rd, pp * 2, c * (KA * 2), 0); __builtin_amdgcn_raw_buffer_store_b16((short)(cvt_pk_bf16(xi, xi) & 0xffffu), rd, pp * 2, c * (KA * 2) + 128, 0);
        const float a = c < NREG ? sr[c < NREG ? c : 0] : tr[c < NREG ? 0 : c - NREG], bq = c < NREG ? si[c < NREG ? c : 0] : ti[c < NREG ? 0 : c - NREG];
        const float nr = A16.x * xr - A16.y * xi + a, ni = A16.x * xi + A16.y * xr + bq; xr = nr; xi = ni; }
    __syncthreads();
}

template <int MODE, class Sched> __device__ __forceinline__ void fixup_local(const float* halo, const float* cw, const float* cb, bf16_t* out, int C, const Sched& S) {
    const int C4 = C >> 2, tid = otid(); Unit u;
    for (int i = 0; S.next(i, u); ++i)
        for (int idx = tid; idx < 8 * C4; idx += 512) {
            const int c = (idx % C4) * 4, ri = idx / C4, q = ri & 1, s = 4 * u.pm + (ri >> 1);
            const float* hb = halo + (size_t)s * 6 * C + c; const bool first = (s & 127) == 0;
            const f32x4 z = (f32x4){0.f, 0.f, 0.f, 0.f};
            const f32x4 t0 = first ? z : *(const f32x4*)(hb - (size_t)6 * C), t1 = first ? z : *(const f32x4*)(hb - (size_t)5 * C);
            const f32x4 h0 = *(const f32x4*)(hb + (size_t)2 * C), h1 = *(const f32x4*)(hb + (size_t)3 * C);
            const f32x4 y = *(const f32x4*)(hb + (size_t)(4 + q) * C);
            const f32x4 x0 = q ? h1 : h0, x1 = q ? h0 : t1, x2 = q ? t1 : t0;
            const f32x4 w0 = *(const f32x4*)(cw + c), w1 = *(const f32x4*)(cw + C + c), w2 = *(const f32x4*)(cw + 2 * C + c);
            f32x4 bb = z; if (MODE == 0) bb = *(const f32x4*)(cb + c);
            float o[4];
#pragma unroll
            for (int j = 0; j < 4; ++j) { const float cv = w2[j] * x0[j] + w1[j] * x1[j] + w0[j] * x2[j] + bb[j]; o[j] = MODE == 0 ? silu_f(cv) * y[j] : cv * y[j]; }
            u32x2 w; w.x = cvt_pk_bf16(o[0], o[1]); w.y = cvt_pk_bf16(o[2], o[3]);
            *(u32x2*)(out + ((size_t)s * 64 + q) * C + c) = w;
        }
    asm volatile("s_waitcnt vmcnt(0)" ::: "memory");
    __syncthreads();
}

__device__ __forceinline__ void final_phase(float* out, const bf16_t* HB, const float* ssq, const float* gf) {
    for (int idx = blockIdx.x * 512 + otid(); idx < MTOK * 128; idx += gridDim.x * 512) {
        const int r = idx >> 7, c = (idx & 127) * 8;
        const float rs = rsqrtf(ssq[r] * (1.0f / DM) + RMS_EPS);
        const u32x4 q = __builtin_nontemporal_load((const u32x4*)(HB + (size_t)idx * 8)); const f32x4 g0 = *(const f32x4*)(gf + c), g1 = *(const f32x4*)(gf + c + 4);
        f32x4 v0 = (f32x4){bf_lo(q.x), bf_hi(q.x), bf_lo(q.y), bf_hi(q.y)}, v1 = (f32x4){bf_lo(q.z), bf_hi(q.z), bf_lo(q.w), bf_hi(q.w)};
        v0 *= g0 * rs; v1 *= g1 * rs;
        __builtin_nontemporal_store(v0, (f32x4*)(out + (size_t)idx * 8)); __builtin_nontemporal_store(v1, (f32x4*)(out + (size_t)idx * 8 + 4));
    }
}

__global__ void __launch_bounds__(512, 2) fwd_megakernel(Params p) {
    extern __shared__ __attribute__((aligned(16))) unsigned char smem[];
    LAS unsigned char* lds = (LAS unsigned char*)smem;
    unsigned* bar = (unsigned*)(p.ws + WS_CTL);
    volatile LAS unsigned* xst = (volatile LAS unsigned*)(lds + STAGE_BYTES);
    const unsigned xcc = xb_xcc_id();
    if (threadIdx.x == 0) { xst[0] = 0u; xst[1] = 0u; (void)xb_add(&bar[XB_XCNT(xcc)], 1u); }
    __syncthreads();
#define GRID_SYNC() grid_bar(bar, xcc, xst)
    float* ssq = (float*)(p.ws + WS_SSQ);
    bf16_t* AP = (bf16_t*)(p.ws + WS_AP); float* Sbuf = (float*)(p.ws + WS_S);
    bf16_t* Z = (bf16_t*)(p.ws + WS_Z); bf16_t* HB = (bf16_t*)(p.ws + WS_HB); bf16_t* ACT = (bf16_t*)(p.ws + WS_ACT);
    float* halo = (float*)(p.ws + WS_HALO);

    prep_phase(p, lds);
    if (p.ws == nullptr) cg::this_grid().sync();
    GRID_SYNC();
    for (int it = blockIdx.x; it < NG * 4; it += gridDim.x) {
        S5PairOrder S; S.init(it, 256); EpiS5a E{Sbuf}; gemm_phase<0>(lds, AP, KA, (const bf16_t*)(p.ws + WS_BTA), 256, S, E);
        asm volatile("s_waitcnt vmcnt(0)" ::: "memory"); __syncthreads();
        scan_item(p, it >> 2, it & 3, lds);
    }
    GRID_SYNC();
    { S5Order S; S.init(384); EpiS5b E{AP, p.s5_d, Z}; gemm_phase(lds, AP, KA, (const bf16_t*)(p.ws + WS_BTB), 384, S, E); }
    GRID_SYNC();
    { StdOrder S; S.init(MTOK, 2048, 1024, 1024); EpiGlu E{p.x, HB, ssq}; gemm_phase(lds, Z, 1024, (const bf16_t*)(p.ws + WS_WGLU), 1024, S, E); }
    GRID_SYNC();
    { StdOrder S; S.init(MTOK, 5632, 1024, 1024); EpiConv<0> E{ssq, p.ffn_conv_w, p.ffn_conv_b, ACT, halo, DFF}; gemm_phase(lds, HB, 1024, (const bf16_t*)(p.ws + WS_WUP0), 1024, S, E); }
    GRID_SYNC();
    { StdOrder S; S.init(MTOK, 1024, 2816, 2816); fixup_local<0>(halo, p.ffn_conv_w, p.ffn_conv_b, ACT, DFF, S); EpiRes<false> E{HB, ssq + MTOK}; gemm_phase(lds, ACT, 2816, (const bf16_t*)(p.ws + WS_WDN0), 2816, S, E); }
    GRID_SYNC();
    { StdOrder S; S.init(MTOK, 4096, 1024, 1024); EpiConv<1> E{ssq + MTOK, p.sc_conv, nullptr, Z, halo, DM}; gemm_phase<1>(lds, HB, 1024, (const bf16_t*)(p.ws + WS_WIN), 1024, S, E); }
    GRID_SYNC();
    { StdOrder S; S.init(MTOK, 1024, 1024, 1024); fixup_local<1>(halo, p.sc_conv, nullptr, Z, DM, S); EpiRes<false> E{HB, ssq + 2 * MTOK}; gemm_phase(lds, Z, 1024, (const bf16_t*)(p.ws + WS_WOUT), 1024, S, E); }
    GRID_SYNC();
    { StdOrder S; S.init(MTOK, 5632, 1024, 1024); EpiConv<0> E{ssq + 2 * MTOK, p.ffn_conv_w + 3 * DFF, p.ffn_conv_b + DFF, ACT, halo, DFF}; gemm_phase(lds, HB, 1024, (const bf16_t*)(p.ws + WS_WUP1), 1024, S, E); }
    GRID_SYNC();
    { StdOrder S; S.init(MTOK, 1024, 2816, 2816); fixup_local<0>(halo, p.ffn_conv_w + 3 * DFF, p.ffn_conv_b + DFF, ACT, DFF, S); EpiRes<true> E{HB, ssq + 3 * MTOK}; gemm_phase(lds, ACT, 2816, (const bf16_t*)(p.ws + WS_WDN1), 2816, S, E); }
    GRID_SYNC();
    final_phase(p.out, HB, ssq + 3 * MTOK, p.norm_final);
#undef GRID_SYNC
}

extern "C" void kernel_launch(void* const* d_in, const int* in_sizes, int n_in, void* d_out, int out_size, void* d_ws, size_t ws_size, hipStream_t stream) {
    constexpr int LDS_BYTES = STAGE_BYTES + 64 + 8192;
    static int grid = 0;
    if (grid == 0) {
        if (n_in != 20 || out_size != MTOK * DM || ws_size < WS_END) { fprintf(stderr, "kernel_launch: unexpected shapes (n_in %d out %d ws %zu need %zu)\n", n_in, out_size, ws_size, (size_t)WS_END); grid = -1; return; }
        int dev = 0, cus = 0, per_cu = 0;
        (void)hipGetDevice(&dev); (void)hipDeviceGetAttribute(&cus, hipDeviceAttributeMultiprocessorCount, dev);
        if (hipFuncSetAttribute((const void*)fwd_megakernel, hipFuncAttributeMaxDynamicSharedMemorySize, LDS_BYTES) != hipSuccess) { fprintf(stderr, "kernel_launch: hipFuncSetAttribute failed\n"); grid = -1; return; }
        (void)hipOccupancyMaxActiveBlocksPerMultiprocessor(&per_cu, (const void*)fwd_megakernel, 512, LDS_BYTES);
        if (per_cu < 1) { fprintf(stderr, "kernel_launch: occupancy query says %d blocks per CU\n", per_cu); per_cu = 1; }
        (void)hipGetLastError();
        grid = cus;
    }
    if (grid < 0) return;
    (void)hipMemsetAsync((char*)d_ws + WS_CTL, 0, 16384, stream);
    Params p{};
    p.x = (const float*)d_in[0]; p.norm_mix = (const float*)d_in[1]; p.norm_ffn = (const float*)d_in[2]; p.norm_final = (const float*)d_in[3];
    p.a_re = (const float*)d_in[4]; p.a_im = (const float*)d_in[5]; p.log_dt = (const float*)d_in[6]; p.b_re = (const float*)d_in[7]; p.b_im = (const float*)d_in[8];
    p.c_re = (const float*)d_in[9]; p.c_im = (const float*)d_in[10]; p.s5_d = (const float*)d_in[11]; p.w_glu = (const float*)d_in[12];
    p.w_in = (const float*)d_in[13]; p.sc_conv = (const float*)d_in[14]; p.w_out = (const float*)d_in[15];
    p.w_up = (const float*)d_in[16]; p.ffn_conv_w = (const float*)d_in[17]; p.ffn_conv_b = (const float*)d_in[18]; p.w_down = (const float*)d_in[19];
    p.out = (float*)d_out; p.ws = (unsigned char*)d_ws;
    void* args[] = {&p};
    hipError_t e = hipLaunchCooperativeKernel((const void*)fwd_megakernel, dim3(grid), dim3(512), args, LDS_BYTES, stream);
    if (e != hipSuccess) fprintf(stderr, "cooperative launch failed: %s (grid %d)\n", hipGetErrorString(e), grid);
}
```

```cpp
#include <hip/hip_runtime.h>
#include <hip/hip_cooperative_groups.h>
#include <cstdio>
namespace cg = cooperative_groups;

#define LAS __attribute__((address_space(3)))
typedef unsigned short bf16_t;
typedef short bf16x8 __attribute__((ext_vector_type(8)));
typedef float f32x4 __attribute__((ext_vector_type(4)));
typedef float f32x2 __attribute__((ext_vector_type(2)));
typedef unsigned u32x4 __attribute__((ext_vector_type(4)));
typedef unsigned u32x2 __attribute__((ext_vector_type(2)));

constexpr int MTOK = 32768, DM = 1024, DFF = 2816, NG = 64, NP = 64, NROW = 2048  , KA = 384  ;
constexpr float RMS_EPS = 1e-6f;

constexpr size_t WS_CTL   = 0;
constexpr size_t WS_SSQ   = 16384;
constexpr size_t WS_WGLU  = WS_SSQ + 4ull * MTOK * 4;
constexpr size_t WS_WUP0  = WS_WGLU + 2048ull * 1024 * 2;
constexpr size_t WS_WUP1  = WS_WUP0 + 5632ull * 1024 * 2;
constexpr size_t WS_WDN0  = WS_WUP1 + 5632ull * 1024 * 2;
constexpr size_t WS_WDN1  = WS_WDN0 + 1024ull * 2816 * 2;
constexpr size_t WS_WIN   = WS_WDN1 + 1024ull * 2816 * 2;
constexpr size_t WS_WOUT  = WS_WIN + 4096ull * 1024 * 2;
constexpr size_t WS_BTA   = WS_WOUT + 1024ull * 1024 * 2;
constexpr size_t WS_BTB   = WS_BTA + 64ull * 256 * 256 * 2;
constexpr size_t WS_Z     = WS_BTB + 64ull * 256 * 384 * 2;
constexpr size_t WS_HB    = WS_Z + (size_t)MTOK * 1024 * 2;
constexpr size_t WS_HALO  = WS_HB + (size_t)MTOK * 1024 * 2;
constexpr size_t WS_R1    = WS_HALO + 512ull * 6 * 2816 * 4;
constexpr size_t WS_AP    = WS_R1;
constexpr size_t WS_S     = WS_AP + 64ull * 2048 * 384 * 2;
constexpr size_t WS_ACT   = WS_R1;
constexpr size_t WS_R1_SZ = (64ull * 2048 * 384 * 2 + 64ull * 2048 * 128 * 4) > ((size_t)MTOK * 2816 * 2) ? (64ull * 2048 * 384 * 2 + 64ull * 2048 * 128 * 4) : ((size_t)MTOK * 2816 * 2);
constexpr size_t WS_END   = WS_R1 + WS_R1_SZ;

__device__ __forceinline__ unsigned cvt_pk_bf16(float lo, float hi) { unsigned r; asm volatile("v_cvt_pk_bf16_f32 %0, %1, %2" : "=v"(r) : "v"(lo), "v"(hi)); return r; }
__device__ __forceinline__ float bf_lo(unsigned w) { return __uint_as_float(w << 16); }
__device__ __forceinline__ float bf_hi(unsigned w) { return __uint_as_float(w & 0xffff0000u); }
__device__ __forceinline__ float fast_sigmoid(float x) { return __builtin_amdgcn_rcpf(1.0f + __builtin_amdgcn_exp2f(x * -1.44269504f)); }
__device__ __forceinline__ float gelu_tanh(float y) { const float t = y * (-2.302208198f + -0.1029432397f * (y * y)); return y * __builtin_amdgcn_rcpf(1.0f + __builtin_amdgcn_exp2f(t)); }
__device__ __forceinline__ float silu_f(float x) { return x * __builtin_amdgcn_rcpf(1.0f + __builtin_amdgcn_exp2f(x * -1.44269504f)); }
template <int CTRL> __device__ __forceinline__ float dpp_mov(float old, float x) { return __int_as_float(__builtin_amdgcn_update_dpp(__float_as_int(old), __float_as_int(x), CTRL, 0xf, 0xf, false)); }
__device__ __forceinline__ int otid() { int t = threadIdx.x; asm volatile("" : "+v"(t)); return t; }
#define XB_XCNT(j)  (256  + 64 * (j))
#define XB_XSUB(j)  (1280 + 64 * (j))
#define XB_XGEN(j)  (2304 + 64 * (j))
#define XB_TOP      3328
#define XB_TOPGEN   3392
#define XCD_BAR_WORDS 3456
__device__ __forceinline__ unsigned xb_ld(unsigned* p)              { return __hip_atomic_load(p, __ATOMIC_RELAXED, __HIP_MEMORY_SCOPE_AGENT); }
__device__ __forceinline__ unsigned xb_add(unsigned* p, unsigned v) { return __hip_atomic_fetch_add(p, v, __ATOMIC_RELAXED, __HIP_MEMORY_SCOPE_AGENT); }
__device__ __forceinline__ unsigned xb_xcc_id() { return (unsigned)__builtin_amdgcn_s_getreg((3 << 11) | 20) & 0xFu; }
__device__ __forceinline__ void xb_complete(unsigned* bar, unsigned x, unsigned& nloc, unsigned& nx) {
    const unsigned G = gridDim.x; unsigned sum, cnt, mine;
    for (;;) { sum = 0u; cnt = 0u; mine = 0u;
#pragma unroll
        for (unsigned j = 0; j < 16; ++j) { const unsigned c = xb_ld(&bar[XB_XCNT(j)]); sum += c; cnt += (c > 0u) ? 1u : 0u; mine = (j == x) ? c : mine; }
        if (sum == G) break;
        __builtin_amdgcn_s_sleep(1); }
    nloc = mine > 0u ? mine : 1u; nx = cnt > 0u ? cnt : 1u;
}
__device__ __forceinline__ void grid_bar(unsigned* bar, unsigned x, volatile LAS unsigned* st) {
    asm volatile("s_waitcnt vmcnt(0) lgkmcnt(0)" ::: "memory");
    __syncthreads();
    if (threadIdx.x == 0) {
        __builtin_amdgcn_s_waitcnt(0);
        unsigned nloc = st[0], nx = st[1];
        if (nloc == 0u) { xb_complete(bar, x, nloc, nx); st[0] = nloc; st[1] = nx; }
        const unsigned old = xb_add(&bar[XB_XSUB(x)], 1u);
        const unsigned gen = old / nloc;
        if (old + 1u == (gen + 1u) * nloc) {
            __builtin_amdgcn_fence(__ATOMIC_RELEASE, "agent");
            asm volatile("s_waitcnt vmcnt(0)" ::: "memory");
            const unsigned og = xb_add(&bar[XB_TOP], 1u);
            const unsigned tg = og / nx;
            if (og + 1u == (tg + 1u) * nx) xb_add(&bar[XB_TOPGEN], 1u);
            else while (xb_ld(&bar[XB_TOPGEN]) == tg) __builtin_amdgcn_s_sleep(1);
            __builtin_amdgcn_fence(__ATOMIC_ACQUIRE, "agent");
            xb_add(&bar[XB_XGEN(x)], 1u);
            asm volatile("s_waitcnt vmcnt(0)" ::: "memory");
        } else {
            while (xb_ld(&bar[XB_XGEN(x)]) == gen) __builtin_amdgcn_s_sleep(1);
            __builtin_amdgcn_fence(__ATOMIC_ACQUIRE, "agent");
            asm volatile("s_waitcnt vmcnt(0)" ::: "memory");
        }
    }
    __syncthreads();
}

constexpr int BM = 256, BK = 64, HALF = 128, HTB = HALF * BK * 2, STAGE_BYTES = 8 * HTB, NXCD = 8, WGM = 8;
__device__ __forceinline__ int lds_byte(int r, int c) { const int st = (r >> 4) * 2 + (c >> 5), rr = r & 15, cc = c & 31, ob = rr * 64 + cc * 2; return st * 1024 + (ob ^ (((ob >> 9) & 1) << 5)); }
__device__ __forceinline__ void stage_rc(int b, int& R, int& C) { const int st = b / 1024, sb = b % 1024, swz = sb ^ (((sb >> 9) & 1) << 5); R = (st >> 1) * 16 + swz / 64; C = (st & 1) * 32 + (swz % 64) / 2; }

struct Unit { int pm, pn, g; };
struct StdOrder {
    int nM, nN, nwg, G, c; size_t atile, btile;
    __device__ __forceinline__ void init(int M, int N, int lda, int K) { nM = M / BM; nN = N / BM; nwg = nM * nN; G = gridDim.x; c = blockIdx.x; asm volatile("" : "+s"(c), "+s"(nN));     atile = (size_t)BM * lda * 2; btile = (size_t)BM * K * 2; }
    __device__ __forceinline__ bool next(int i, Unit& u) const {
        const long L = (long)i * G + c; if (L >= nwg) return false;
        int wgid = (int)L; { const int q = nwg / NXCD, r = nwg % NXCD, xcd = wgid % NXCD, off = wgid / NXCD; wgid = (xcd < r ? xcd * (q + 1) : r * (q + 1) + (xcd - r) * q) + off; }
        const int nig = WGM * nN, gid = wgid / nig, fm = gid * WGM, gsz = (nM - fm) < WGM ? (nM - fm) : WGM;
        u.pm = __builtin_amdgcn_readfirstlane(fm + ((wgid % nig) % gsz)); u.pn = __builtin_amdgcn_readfirstlane((wgid % nig) / gsz); u.g = 0; return true;
    }
    __device__ __forceinline__ size_t a_off(const Unit& u) const { return (size_t)u.pm * atile; }
    __device__ __forceinline__ size_t b_off(const Unit& u) const { return (size_t)u.pn * btile; }
};
struct S5Order {
    int G, c; size_t btile;
    __device__ __forceinline__ void init(int K) { G = gridDim.x; c = blockIdx.x; asm volatile("" : "+s"(c)); btile = (size_t)BM * K * 2; }
    __device__ __forceinline__ bool next(int i, Unit& u) const { const long L = (long)i * G + c; if (L >= NG * 8) return false; u.g = (int)(L >> 3); u.pm = (int)(L & 7); u.pn = 0; return true; }
    __device__ __forceinline__ size_t a_off(const Unit& u) const { return ((size_t)u.g * NROW + (size_t)u.pm * BM) * KA * 2; }
    __device__ __forceinline__ size_t b_off(const Unit& u) const { return (size_t)u.g * btile; }
};

struct S5PairOrder {
    int g, b; size_t btile;
    __device__ __forceinline__ void init(int it, int K) { g = it >> 2; b = it & 3; btile = (size_t)BM * K * 2; }
    __device__ __forceinline__ bool next(int i, Unit& u) const { if (i >= 2) return false; u.g = g; u.pm = 2 * b + i; u.pn = 0; return true; }
    __device__ __forceinline__ size_t a_off(const Unit& u) const { return ((size_t)u.g * NROW + (size_t)u.pm * BM) * KA * 2; }
    __device__ __forceinline__ size_t b_off(const Unit& u) const { return (size_t)u.g * btile; }
};

template <int NB1 = 2, class Epi, class Sched>
__device__ __forceinline__ void gemm_phase(LAS unsigned char* lds, const bf16_t* Ap, int lda, const bf16_t* Btp, int K, const Sched& S, const Epi& E) {
    int tid_ = threadIdx.x; asm volatile("" : "+v"(tid_));
    const int tid = tid_, wid = __builtin_amdgcn_readfirstlane(tid >> 6), lane = tid & 63, wr = wid >> 2, wc = wid & 3, fr = lane & 15, fq = lane >> 4;
    asm volatile("" : "+s"(K), "+s"(lda));
    const int nt = K / BK;
    unsigned voffA[2], voffB[2];
#pragma unroll
    for (int i = 0; i < 2; ++i) { int R, C; stage_rc(tid * 16 + i * 8192, R, C); voffA[i] = (unsigned)(R * lda + C) * 2u; voffB[i] = (unsigned)(R * K + C) * 2u; }
    const size_t kstep = (size_t)(BK * 2);
    const size_t hstepA = (size_t)HALF * lda * 2, hstepB = (size_t)HALF * K * 2;
    const unsigned ldsw = (unsigned)wid * 1024u;
    const int aoff = lds_byte(wr * 64 + fr, fq * 8), boff = lds_byte(wc * 32 + fr, fq * 8);
#define PG8_SA(b, h) (((b) * 2 + (h)) * HTB)
#define PG8_SB(b, h) ((4 + (b) * 2 + (h)) * HTB)
#define PG8_STAGE(bufoff, gbase, voff) do { const __amdgpu_buffer_rsrc_t _r = __builtin_amdgcn_make_buffer_rsrc((void*)(gbase), (short)0, 0x7fffffff, 0x00020000); _Pragma("unroll") for (int _i = 0; _i < 2; ++_i) \
        __builtin_amdgcn_raw_ptr_buffer_load_lds(_r, (LAS unsigned*)(lds + (bufoff) + ldsw + _i * 8192), 16, (int)(voff)[_i], 0, 0, 0); } while (0)
#define PG8_LDA(dst, b, h) do { _Pragma("unroll") for (int m = 0; m < 4; ++m) _Pragma("unroll") for (int k = 0; k < 2; ++k) dst[m][k] = *(const LAS bf16x8*)(lds + PG8_SA(b, h) + aoff + m * 2048 + k * 1024); } while (0)
#define PG8_LDB(dst, b, h) do { _Pragma("unroll") for (int n = 0; n < 2; ++n) _Pragma("unroll") for (int k = 0; k < 2; ++k) dst[n][k] = *(const LAS bf16x8*)(lds + PG8_SB(b, h) + boff + n * 2048 + k * 1024); } while (0)
#define PG8_MMA(ai, bj, At, Bt) do { __builtin_amdgcn_s_setprio(1); _Pragma("unroll") for (int k = 0; k < 2; ++k) _Pragma("unroll") for (int m = 0; m < 4; ++m) _Pragma("unroll") for (int n = 0; n < ((bj) == 1 ? NB1 : 2); ++n) \
        acc[ai][bj][m][n] = __builtin_amdgcn_mfma_f32_16x16x32_bf16(Bt[n][k], At[m][k], acc[ai][bj][m][n], 0, 0, 0); __builtin_amdgcn_s_setprio(0); } while (0)
#define PG8_WAIT_V(n) asm volatile("s_waitcnt vmcnt(" #n ")" ::: "memory")
#define PG8_WAIT_L(n) asm volatile("s_waitcnt lgkmcnt(" #n ")" ::: "memory")
#define PG8_BAR __builtin_amdgcn_s_barrier()
#define PG8_SCHED __builtin_amdgcn_sched_barrier(0)
    Unit cur, nxt; int ui = 0;
    if (!S.next(0, cur)) return;
    f32x4 epar = E.prefetch(cur, wr, wc, lane);
    f32x4 acc[2][2][4][2];
#pragma unroll
    for (int a = 0; a < 2; ++a)
#pragma unroll
        for (int b = 0; b < 2; ++b)
#pragma unroll
            for (int m = 0; m < 4; ++m)
#pragma unroll
                for (int n = 0; n < 2; ++n) acc[a][b][m][n] = (f32x4){0.f, 0.f, 0.f, 0.f};
    bf16x8 At[4][2], B0[2][2], B1[2][2];
    const char* cA = (const char*)Ap + S.a_off(cur); const char* cB = (const char*)Btp + S.b_off(cur);
    PG8_STAGE(PG8_SB(0, 0), cB, voffB); PG8_STAGE(PG8_SA(0, 0), cA, voffA); PG8_STAGE(PG8_SB(0, 1), cB + hstepB, voffB); PG8_STAGE(PG8_SA(0, 1), cA + hstepA, voffA);
    if (wr == 1) PG8_BAR;
    PG8_WAIT_V(4); PG8_BAR;
    PG8_STAGE(PG8_SB(1, 0), cB + kstep, voffB); PG8_STAGE(PG8_SA(1, 0), cA + kstep, voffA); PG8_STAGE(PG8_SB(1, 1), cB + hstepB + kstep, voffB);
    PG8_WAIT_V(6); PG8_BAR;
    for (;;) {
        const bool has_next = S.next(ui + 1, nxt);
        const char* nA = has_next ? (const char*)Ap + S.a_off(nxt) : cA; const char* nB = has_next ? (const char*)Btp + S.b_off(nxt) : cB;
        for (int t = 0; t < nt; t += 2) {
            const bool last = (t == nt - 2);
            const char* a1 = cA + (size_t)(t + 1) * kstep;
            const char* a2 = last ? nA : cA + (size_t)(t + 2) * kstep; const char* b2 = last ? nB : cB + (size_t)(t + 2) * kstep;
            const char* a3 = a2 + kstep; const char* b3 = b2 + kstep;
            PG8_LDB(B0, 0, 0); PG8_SCHED; PG8_LDA(At, 0, 0); PG8_STAGE(PG8_SA(1, 1), a1 + hstepA, voffA);
            PG8_WAIT_L(8); PG8_BAR; PG8_WAIT_L(0); PG8_MMA(0, 0, At, B0); PG8_BAR; PG8_SCHED;
            PG8_LDB(B1, 0, 1); PG8_STAGE(PG8_SB(0, 0), b2, voffB);
            PG8_BAR; PG8_WAIT_L(0); PG8_MMA(0, 1, At, B1); PG8_BAR;
            PG8_LDA(At, 0, 1); PG8_STAGE(PG8_SA(0, 0), a2, voffA);
            PG8_BAR; PG8_WAIT_L(0); PG8_MMA(1, 0, At, B0); PG8_BAR; PG8_SCHED;
            PG8_STAGE(PG8_SB(0, 1), b2 + hstepB, voffB);
            PG8_WAIT_V(6); PG8_BAR; PG8_MMA(1, 1, At, B1); PG8_BAR;
            PG8_LDB(B0, 1, 0); PG8_SCHED; PG8_LDA(At, 1, 0); PG8_STAGE(PG8_SA(0, 1), a2 + hstepA, voffA);
            PG8_WAIT_L(8); PG8_BAR; PG8_WAIT_L(0); PG8_MMA(0, 0, At, B0); PG8_BAR; PG8_SCHED;
            PG8_LDB(B1, 1, 1); PG8_STAGE(PG8_SB(1, 0), b3, voffB);
            PG8_BAR; PG8_WAIT_L(0); PG8_MMA(0, 1, At, B1); PG8_BAR;
            PG8_LDA(At, 1, 1); PG8_STAGE(PG8_SA(1, 0), a3, voffA);
            PG8_BAR; PG8_WAIT_L(0); PG8_MMA(1, 0, At, B0); PG8_BAR; PG8_SCHED;
            PG8_STAGE(PG8_SB(1, 1), b3 + hstepB, voffB);
            PG8_WAIT_V(6); PG8_BAR; PG8_MMA(1, 1, At, B1); PG8_BAR;
        }
        E(acc, cur, wr, wc, fr, fq, lds, epar);
        if (has_next) epar = E.prefetch(nxt, wr, wc, lane);
        if (!has_next) break;
#pragma unroll
        for (int a = 0; a < 2; ++a)
#pragma unroll
            for (int b = 0; b < 2; ++b)
#pragma unroll
                for (int m = 0; m < 4; ++m)
#pragma unroll
                    for (int n = 0; n < 2; ++n) acc[a][b][m][n] = (f32x4){0.f, 0.f, 0.f, 0.f};
        cur = nxt; cA = nA; cB = nB; ++ui;
    }
    PG8_WAIT_V(0);
    if (wr == 0) PG8_BAR;
    PG8_BAR;
#undef PG8_SA
#undef PG8_SB
#undef PG8_STAGE
#undef PG8_LDA
#undef PG8_LDB
#undef PG8_MMA
#undef PG8_WAIT_V
#undef PG8_WAIT_L
#undef PG8_BAR
#undef PG8_SCHED
}

typedef f32x4 Acc[2][2][4][2];

struct EpiS5a {
    __device__ __forceinline__ f32x4 prefetch(const Unit&, int, int, int) const { return (f32x4){0.f, 0.f, 0.f, 0.f}; }
    float* S;
    __device__ __forceinline__ void operator()(const Acc& acc, const Unit& u, int wr, int wc, int fr, int fq, LAS unsigned char* lds, f32x4 epar) const {
        const int row0 = u.g * NROW + u.pm * BM + wr * 64 + fr, col0 = wc * 32 + 4 * fq;
#pragma unroll
        for (int ai = 0; ai < 2; ++ai)
#pragma unroll
            for (int m = 0; m < 4; ++m) { float* rowp = S + (size_t)(row0 + ai * HALF + m * 16) * 128 + col0;
#pragma unroll
                for (int n = 0; n < 2; ++n) *(f32x4*)(rowp + n * 16) = acc[ai][0][m][n]; }
    }
};
struct EpiS5b {
    __device__ __forceinline__ f32x4 prefetch(const Unit&, int, int, int) const { return (f32x4){0.f, 0.f, 0.f, 0.f}; }
    const bf16_t* AP; const float* dskip; bf16_t* Z;
    __device__ __forceinline__ void operator()(const Acc& acc, const Unit& u, int wr, int wc, int fr, int fq, LAS unsigned char* lds, f32x4 epar) const {
        const int h0 = 8 * (fq & 1);
        const f32x4 d0 = *(const f32x4*)(dskip + u.g * 16 + h0), d1 = *(const f32x4*)(dskip + u.g * 16 + h0 + 4);
        u32x4 uu[2][4][2];
#pragma unroll
        for (int ai = 0; ai < 2; ++ai)
#pragma unroll
            for (int m = 0; m < 4; ++m) { const int Rg = u.pm * BM + ai * HALF + wr * 64 + m * 16 + fr;
#pragma unroll
                for (int bj = 0; bj < 2; ++bj) { const int t = 8 * bj + 2 * wc + (fq >> 1); uu[ai][m][bj] = *(const u32x4*)(AP + ((size_t)u.g * NROW + Rg) * KA + t * 16 + h0); } }
#pragma unroll
        for (int ai = 0; ai < 2; ++ai)
#pragma unroll
            for (int m = 0; m < 4; ++m) { const int Rg = u.pm * BM + ai * HALF + wr * 64 + m * 16 + fr;
#pragma unroll
                for (int bj = 0; bj < 2; ++bj) { const int t = 8 * bj + 2 * wc + (fq >> 1);
                    const u32x4 q = uu[ai][m][bj];
                    const f32x4 a0 = acc[ai][bj][m][0], a1 = acc[ai][bj][m][1];
                    float y[8];
                    y[0] = a0[0] + d0[0] * bf_lo(q.x); y[1] = a0[1] + d0[1] * bf_hi(q.x); y[2] = a0[2] + d0[2] * bf_lo(q.y); y[3] = a0[3] + d0[3] * bf_hi(q.y);
                    y[4] = a1[0] + d1[0] * bf_lo(q.z); y[5] = a1[1] + d1[1] * bf_hi(q.z); y[6] = a1[2] + d1[2] * bf_lo(q.w); y[7] = a1[3] + d1[3] * bf_hi(q.w);
#pragma unroll
                    for (int i = 0; i < 8; ++i) y[i] = gelu_tanh(y[i]);
                    u32x4 w; w.x = cvt_pk_bf16(y[0], y[1]); w.y = cvt_pk_bf16(y[2], y[3]); w.z = cvt_pk_bf16(y[4], y[5]); w.w = cvt_pk_bf16(y[6], y[7]);
                    *(u32x4*)(Z + ((size_t)Rg * 16 + t) * DM + u.g * 16 + h0) = w; } }
    }
};
struct EpiGlu {
    __device__ __forceinline__ f32x4 prefetch(const Unit&, int, int, int) const { return (f32x4){0.f, 0.f, 0.f, 0.f}; }
    const float* x; bf16_t* HB; float* ssq;
    __device__ __forceinline__ void operator()(const Acc& acc, const Unit& u, int wr, int wc, int fr, int fq, LAS unsigned char* lds, f32x4 epar) const {
        const int c0 = u.pn * 128 + wc * 32 + 8 * fq;
        f32x4 xv[2][4][2];
#pragma unroll
        for (int ai = 0; ai < 2; ++ai)
#pragma unroll
            for (int m = 0; m < 4; ++m) { const int r = u.pm * BM + ai * HALF + wr * 64 + m * 16 + fr; const size_t off = (size_t)r * DM + c0;
                xv[ai][m][0] = __builtin_nontemporal_load((const f32x4*)(x + off)); xv[ai][m][1] = __builtin_nontemporal_load((const f32x4*)(x + off + 4)); }
#pragma unroll
        for (int ai = 0; ai < 2; ++ai)
#pragma unroll
            for (int m = 0; m < 4; ++m) { const int r = u.pm * BM + ai * HALF + wr * 64 + m * 16 + fr; const size_t off = (size_t)r * DM + c0;
                f32x4 v0 = xv[ai][m][0], v1 = xv[ai][m][1];
                const f32x4 za0 = acc[ai][0][m][0], za1 = acc[ai][0][m][1], zg0 = acc[ai][1][m][0], zg1 = acc[ai][1][m][1];
#pragma unroll
                for (int j = 0; j < 4; ++j) { v0[j] += za0[j] * fast_sigmoid(zg0[j]); v1[j] += za1[j] * fast_sigmoid(zg1[j]); }
                u32x4 w; w.x = cvt_pk_bf16(v0[0], v0[1]); w.y = cvt_pk_bf16(v0[2], v0[3]); w.z = cvt_pk_bf16(v1[0], v1[1]); w.w = cvt_pk_bf16(v1[2], v1[3]);
                *(u32x4*)(HB + off) = w;
                float s = (v0[0] * v0[0] + v0[1] * v0[1]) + (v0[2] * v0[2] + v0[3] * v0[3]) + (v1[0] * v1[0] + v1[1] * v1[1]) + (v1[2] * v1[2] + v1[3] * v1[3]);
                s += __shfl_xor(s, 16); s += __shfl_xor(s, 32);
                if (fq == 0) unsafeAtomicAdd(ssq + r, s); }
    }
};
template <bool LAST> struct EpiRes {
    __device__ __forceinline__ f32x4 prefetch(const Unit&, int, int, int) const { return (f32x4){0.f, 0.f, 0.f, 0.f}; }
    bf16_t* HB; float* ssq;
    __device__ __forceinline__ void operator()(const Acc& acc, const Unit& u, int wr, int wc, int fr, int fq, LAS unsigned char* lds, f32x4 epar) const {
        u32x4 hv[2][4][2];
#pragma unroll
        for (int ai = 0; ai < 2; ++ai)
#pragma unroll
            for (int m = 0; m < 4; ++m) { const int r = u.pm * BM + ai * HALF + wr * 64 + m * 16 + fr;
#pragma unroll
                for (int bj = 0; bj < 2; ++bj) hv[ai][m][bj] = *(const u32x4*)(HB + (size_t)r * DM + u.pn * 256 + bj * 128 + wc * 32 + 8 * fq); }
#pragma unroll
        for (int ai = 0; ai < 2; ++ai)
#pragma unroll
            for (int m = 0; m < 4; ++m) { const int r = u.pm * BM + ai * HALF + wr * 64 + m * 16 + fr; float s = 0.f;
#pragma unroll
                for (int bj = 0; bj < 2; ++bj) { const size_t off = (size_t)r * DM + u.pn * 256 + bj * 128 + wc * 32 + 8 * fq;
                    const u32x4 q = hv[ai][m][bj];
                    f32x4 v0 = (f32x4){bf_lo(q.x), bf_hi(q.x), bf_lo(q.y), bf_hi(q.y)}, v1 = (f32x4){bf_lo(q.z), bf_hi(q.z), bf_lo(q.w), bf_hi(q.w)};
                    v0 += acc[ai][bj][m][0]; v1 += acc[ai][bj][m][1];
                    u32x4 w; w.x = cvt_pk_bf16(v0[0], v0[1]); w.y = cvt_pk_bf16(v0[2], v0[3]); w.z = cvt_pk_bf16(v1[0], v1[1]); w.w = cvt_pk_bf16(v1[2], v1[3]);
                    *(u32x4*)(HB + off) = w;
                    s += (v0[0] * v0[0] + v0[1] * v0[1]) + (v0[2] * v0[2] + v0[3] * v0[3]) + (v1[0] * v1[0] + v1[1] * v1[1]) + (v1[2] * v1[2] + v1[3] * v1[3]); }
                s += __shfl_xor(s, 16); s += __shfl_xor(s, 32);
                if (fq == 0) unsafeAtomicAdd(ssq + r, s); }
    }
};
template <int MODE> struct EpiConv {
    const float* ssq; const float* cw; const float* cb; bf16_t* out; float* halo; int C;
    __device__ __forceinline__ f32x4 prefetch(const Unit& u, int wr, int wc, int lane) const {
        const float* ptr;
        if (lane < 32) { const int arr = lane >> 3, j = lane & 7;
            if (MODE == 0) ptr = (arr < 3 ? cw + arr * C : cb) + u.pn * 128 + wc * 32 + 4 * j;
            else ptr = cw + (arr < 3 ? arr : 0) * C + u.pn * 64 + wc * 16 + 4 * (j & 3); }
        else { const int k = lane - 32; ptr = ssq + u.pm * BM + (k >> 4) * HALF + wr * 64 + 4 * (k & 15); }
        f32x4 v; asm volatile("global_load_dwordx4 %0, %1, off" : "=&v"(v) : "v"(ptr) : "memory"); return v;
    }
    __device__ __forceinline__ void operator()(const Acc& acc, const Unit& u, int wr, int wc, int fr, int fq, LAS unsigned char* lds, f32x4 epar) const {
        constexpr int NV = MODE == 0 ? 8 : 4;
        const int c0 = MODE == 0 ? (u.pn * 128 + wc * 32 + 8 * fq) : (u.pn * 64 + wc * 16 + 4 * fq);
        LAS float* pw = (LAS float*)(lds + STAGE_BYTES + 64 + (wr * 4 + wc) * 1024);
        *(LAS f32x4*)(pw + (fq * 16 + fr) * 4) = epar;
        asm volatile("s_waitcnt lgkmcnt(0)" ::: "memory");
        float w0[NV], w1[NV], w2[NV], bb[NV];
#pragma unroll
        for (int i = 0; i < NV; i += 4) { const f32x4 a = *(const LAS f32x4*)(pw + NV * fq + i), b = *(const LAS f32x4*)(pw + 32 + NV * fq + i), c = *(const LAS f32x4*)(pw + 64 + NV * fq + i);
            f32x4 d = (f32x4){0.f, 0.f, 0.f, 0.f}; if (MODE == 0) d = *(const LAS f32x4*)(pw + 96 + NV * fq + i);
#pragma unroll
            for (int j = 0; j < 4; ++j) { w0[i + j] = a[j]; w1[i + j] = b[j]; w2[i + j] = c[j]; bb[i + j] = d[j]; } }
        float sq[2][4];
#pragma unroll
        for (int ai = 0; ai < 2; ++ai)
#pragma unroll
            for (int m = 0; m < 4; ++m) sq[ai][m] = pw[128 + ai * 64 + m * 16 + fr];
#pragma unroll
        for (int ai = 0; ai < 2; ++ai) {
            const int strip = u.pm * 4 + ai * 2 + wr;
            float p1prev[NV], p2prev[NV];
#pragma unroll
            for (int i = 0; i < NV; ++i) { p1prev[i] = 0.f; p2prev[i] = 0.f; }
#pragma unroll
            for (int m = 0; m < 4; ++m) {
                const int r = u.pm * BM + ai * HALF + wr * 64 + m * 16 + fr;
                const float rs = __builtin_amdgcn_rsqf(sq[ai][m] * (1.0f / DM) + RMS_EPS);
                float X[NV], Y[NV], o[NV];
                if (MODE == 0) {
#pragma unroll
                    for (int n = 0; n < 2; ++n)
#pragma unroll
                        for (int j = 0; j < 4; ++j) { X[n * 4 + j] = acc[ai][0][m][n][j] * rs; Y[n * 4 + j] = acc[ai][1][m][n][j] * rs; }
                } else {
#pragma unroll
                    for (int j = 0; j < 4; ++j) { X[j] = (acc[ai][0][m][1][j] * rs) * (acc[ai][1][m][0][j] * rs); Y[j] = acc[ai][0][m][0][j] * rs; }
                }
#pragma unroll
                for (int i = 0; i < NV; ++i) {
                    const float q1 = dpp_mov<0x111>(p1prev[i], X[i]), q2 = dpp_mov<0x112>(p2prev[i], X[i]);
                    p1prev[i] = dpp_mov<0x121>(0.f, X[i]); p2prev[i] = dpp_mov<0x122>(0.f, X[i]);
                    const float cv = w2[i] * X[i] + w1[i] * q1 + w0[i] * q2 + bb[i];
                    o[i] = MODE == 0 ? silu_f(cv) * Y[i] : cv * Y[i];
                }
                if (m == 0 && fr < 2) {
                    float* hx = halo + ((size_t)strip * 6 + 2 + fr) * C + c0; float* hy = halo + ((size_t)strip * 6 + 4 + fr) * C + c0;
#pragma unroll
                    for (int i = 0; i < NV; i += 4) { *(f32x4*)(hx + i) = (f32x4){X[i], X[i + 1], X[i + 2], X[i + 3]}; *(f32x4*)(hy + i) = (f32x4){Y[i], Y[i + 1], Y[i + 2], Y[i + 3]}; }
                } else {
                    if (MODE == 0) { u32x4 w; w.x = cvt_pk_bf16(o[0], o[1]); w.y = cvt_pk_bf16(o[2], o[3]); w.z = cvt_pk_bf16(o[4 % NV], o[5 % NV]); w.w = cvt_pk_bf16(o[6 % NV], o[7 % NV]);
                        __builtin_nontemporal_store(w, (u32x4*)(out + (size_t)r * C + c0)); }
                    else { u32x2 w; w.x = cvt_pk_bf16(o[0], o[1]); w.y = cvt_pk_bf16(o[2], o[3]); __builtin_nontemporal_store(w, (u32x2*)(out + (size_t)r * C + c0)); }
                }
                if (m == 3 && fr >= 14) { float* hx = halo + ((size_t)strip * 6 + (fr - 14)) * C + c0;
#pragma unroll
                    for (int i = 0; i < NV; i += 4) *(f32x4*)(hx + i) = (f32x4){X[i], X[i + 1], X[i + 2], X[i + 3]}; }
            }
        }
    }
};

struct Params {
    const float* x; const float* norm_mix; const float* norm_ffn; const float* norm_final;
    const float* a_re; const float* a_im; const float* log_dt; const float* b_re; const float* b_im; const float* c_re; const float* c_im; const float* s5_d;
    const float* w_glu; const float* w_in; const float* sc_conv; const float* w_out; const float* w_up; const float* ffn_conv_w; const float* ffn_conv_b; const float* w_down;
    float* out; unsigned char* ws;
};

__device__ __forceinline__ f32x2 cpow_n(float lr, float li, float dt, float n) {
    const float mag = __expf(lr * dt * n);
    double tr = (double)li * (double)dt * (double)n * 0.15915494309189535; tr -= rint(tr);
    const float ang = (float)(tr * 6.283185307179586);
    return (f32x2){mag * cosf(ang), mag * sinf(ang)};
}

__device__ __forceinline__ void s5_precompute(const Params& p, int g, LAS unsigned char* lds) {
    LAS f32x2* pw = (LAS f32x2*)lds;
    LAS f32x2* Bb = pw + 17 * 64;
    LAS f32x2* Cc = Bb + 64 * 16;
    LAS f32x2* Gg = Cc + 16 * 64;
    LAS float* Kt = (LAS float*)(Gg + 64);
    const int tid = otid();
    for (int e = tid; e < 17 * 64; e += 512) { const int d = e >> 6, pp = e & 63; pw[e] = cpow_n(p.a_re[g * 64 + pp], p.a_im[g * 64 + pp], expf(p.log_dt[g]), (float)d); }
    if (tid < 64) {
        const float lr = p.a_re[g * 64 + tid], li = p.a_im[g * 64 + tid], dt = expf(p.log_dt[g]);
        double tr = (double)li * (double)dt * 0.15915494309189535; tr -= rint(tr);
        const float th = (float)(tr * 6.283185307179586);
        const float sh = sinf(0.5f * th), cs = cosf(th), sn = sinf(th);
        const float nr = expm1f(lr * dt) * cs - 2.0f * sh * sh, ni = expf(lr * dt) * sn;
        const float den = lr * lr + li * li;
        Gg[tid] = (f32x2){(nr * lr + ni * li) / den, (ni * lr - nr * li) / den};
    }
    __syncthreads();
    for (int i = tid; i < 1024; i += 512) { const int pp = i >> 4; const f32x2 gg = Gg[pp];
        const float br = p.b_re[(size_t)g * 1024 + i], bi = p.b_im[(size_t)g * 1024 + i];
        Bb[i] = (f32x2){gg.x * br - gg.y * bi, gg.x * bi + gg.y * br};
        Cc[i] = (f32x2){p.c_re[(size_t)g * 1024 + i], p.c_im[(size_t)g * 1024 + i]}; }
    __syncthreads();
    for (int e = tid; e < 4096; e += 512) { const int d = e >> 8, h = (e >> 4) & 15, hp = e & 15; float s = 0.f;
        for (int pp = 0; pp < 64; ++pp) { const f32x2 c = Cc[h * 64 + pp], w = pw[d * 64 + pp], b = Bb[pp * 16 + hp];
            const float tr_ = w.x * b.x - w.y * b.y, ti_ = w.x * b.y + w.y * b.x; s += c.x * tr_ - c.y * ti_; }
        Kt[e] = s; }
    __syncthreads();
    bf16_t* BTA = (bf16_t*)(p.ws + WS_BTA) + (size_t)g * 256 * 256;
    bf16_t* BTB = (bf16_t*)(p.ws + WS_BTB) + (size_t)g * 256 * 384;
    for (int pc = tid; pc < 256 * 32; pc += 512) { const int n = pc >> 5, k0 = (pc & 31) * 8; float v[8];
        const int s = k0 >> 4, hp0 = k0 & 15;
#pragma unroll
        for (int i = 0; i < 8; ++i) { float val = 0.f;
            if (n < 128) { const int pp = n & 63; const f32x2 w = pw[(15 - s) * 64 + pp], b = Bb[pp * 16 + hp0 + i];
                val = n < 64 ? (w.x * b.x - w.y * b.y) : (w.x * b.y + w.y * b.x); }
            v[i] = val; }
        u32x4 w4; w4.x = cvt_pk_bf16(v[0], v[1]); w4.y = cvt_pk_bf16(v[2], v[3]); w4.z = cvt_pk_bf16(v[4], v[5]); w4.w = cvt_pk_bf16(v[6], v[7]);
        *(u32x4*)(BTA + (size_t)n * 256 + k0) = w4; }
    for (int pc = tid; pc < 256 * 48; pc += 512) { const int slot = pc / 48, k0 = (pc % 48) * 8; float v[8];
        const int bj = slot >> 7, wc = (slot >> 5) & 3, nn = (slot >> 4) & 1, fq = (slot >> 2) & 3, j = slot & 3;
        const int nout = 128 * bj + 32 * wc + 8 * fq + 4 * nn + j, t = nout >> 4, h = nout & 15;
        if (k0 < 256) { const int s = k0 >> 4, hp0 = k0 & 15;
#pragma unroll
            for (int i = 0; i < 8; ++i) v[i] = s <= t ? Kt[((t - s) * 16 + h) * 16 + hp0 + i] : 0.f;
        } else { const int kp0 = k0 - 256;
#pragma unroll
            for (int i = 0; i < 8; ++i) { const int kp = kp0 + i, pp = kp & 63; const f32x2 c = Cc[h * 64 + pp], w = pw[(t + 1) * 64 + pp];
                v[i] = kp < 64 ? (c.x * w.x - c.y * w.y) : -(c.x * w.y + c.y * w.x); } }
        u32x4 w4; w4.x = cvt_pk_bf16(v[0], v[1]); w4.y = cvt_pk_bf16(v[2], v[3]); w4.z = cvt_pk_bf16(v[4], v[5]); w4.w = cvt_pk_bf16(v[6], v[7]);
        *(u32x4*)(BTB + (size_t)slot * 384 + k0) = w4; }
    __syncthreads();
}

__device__ __forceinline__ int dest_row(int kind, int n, int NPART) {
    if (kind == 0) { const int part = n / NPART, c = n % NPART, pn = c >> 7, cc = c & 127, wc = cc >> 5, r = cc & 31, fq = r >> 3, nn = (r >> 2) & 1, j = r & 3; return pn * 256 + 128 * part + 32 * wc + 16 * nn + 4 * fq + j; }
    if (kind == 1) { const int q = n >> 10, c = n & 1023, pn = c >> 6, cc = c & 63, wc = cc >> 4, r = cc & 15, fq = r >> 2, j = r & 3; return pn * 256 + 128 * (q >> 1) + 32 * wc + 16 * (q & 1) + 4 * fq + j; }
    const int pn = n >> 8, cc = n & 255, bj = cc >> 7, r2 = cc & 127, wc = r2 >> 5, r = r2 & 31, fq = r >> 3, nn = (r >> 2) & 1, j = r & 3; return pn * 256 + 128 * bj + 32 * wc + 16 * nn + 4 * fq + j;
}
constexpr int PI_S5 = 64, PI_GLU = 16 * 8, PI_UP = 16 * 22, PI_DN = 44 * 4, PI_IN = 16 * 12, PI_OUT = 16 * 4;
constexpr int PO_GLU = PI_S5, PO_UP0 = PO_GLU + PI_GLU, PO_UP1 = PO_UP0 + PI_UP, PO_DN0 = PO_UP1 + PI_UP, PO_DN1 = PO_DN0 + PI_DN, PO_IN = PO_DN1 + PI_DN, PO_OUT = PO_IN + PI_IN, PO_NORM = PO_OUT + PI_OUT, PI_ALL = PO_NORM + NROW;
struct WDesc { const float* W; int K, N; bf16_t* Bt; const float* gain; int kind, NPART, kb, nb; };
__device__ __forceinline__ bool item_desc(const Params& p, int it, WDesc& d) {
    if (it >= PO_NORM) return false;
    if (it < PO_UP0) { const int j = it - PO_GLU; d = WDesc{p.w_glu, 1024, 2048, (bf16_t*)(p.ws + WS_WGLU), nullptr, 0, 1024, j / 8, j % 8}; }
    else if (it < PO_UP1) { const int j = it - PO_UP0; d = WDesc{p.w_up, 1024, 5632, (bf16_t*)(p.ws + WS_WUP0), p.norm_ffn, 0, 2816, j / 22, j % 22}; }
    else if (it < PO_DN0) { const int j = it - PO_UP1; d = WDesc{p.w_up + (size_t)1024 * 5632, 1024, 5632, (bf16_t*)(p.ws + WS_WUP1), p.norm_ffn + 1024, 0, 2816, j / 22, j % 22}; }
    else if (it < PO_DN1) { const int j = it - PO_DN0; d = WDesc{p.w_down, 2816, 1024, (bf16_t*)(p.ws + WS_WDN0), nullptr, 2, 0, j / 4, j % 4}; }
    else if (it < PO_IN) { const int j = it - PO_DN1; d = WDesc{p.w_down + (size_t)2816 * 1024, 2816, 1024, (bf16_t*)(p.ws + WS_WDN1), nullptr, 2, 0, j / 4, j % 4}; }
    else if (it < PO_OUT) { const int j = it - PO_IN; d = WDesc{p.w_in, 1024, 3072, (bf16_t*)(p.ws + WS_WIN), p.norm_mix + 1024, 1, 0, j / 12, j % 12}; }
    else { const int j = it - PO_OUT; d = WDesc{p.w_out, 1024, 1024, (bf16_t*)(p.ws + WS_WOUT), nullptr, 2, 0, j / 4, j % 4}; }
    return true;
}
__device__ __forceinline__ void item_load(const Params& p, int it, f32x4 (&v)[8]) {
    const int tid = otid(); WDesc d;
    if (item_desc(p, it, d)) {
#pragma unroll
        for (int i = 0; i < 8; ++i) { const int idx = tid + i * 512, row = idx >> 6, c4 = idx & 63;
            v[i] = __builtin_nontemporal_load((const f32x4*)(d.W + (size_t)(d.kb * 64 + row) * d.N + d.nb * 256 + c4 * 4)); }
    } else {
        const int R = it - PO_NORM, wid = tid >> 6, lane = tid & 63;
#pragma unroll
        for (int q = 0; q < 2; ++q)
#pragma unroll
            for (int i = 0; i < 4; ++i) v[q * 4 + i] = __builtin_nontemporal_load((const f32x4*)(p.x + ((size_t)R * 16 + wid * 2 + q) * DM + i * 256 + lane * 4));
    }
}
__device__ __forceinline__ void item_finish(const Params& p, int it, const f32x4 (&v)[8], LAS unsigned char* lds) {
    const int tid = otid(); WDesc d;
    if (item_desc(p, it, d)) {
        LAS float* tile = (LAS float*)lds;
#pragma unroll
        for (int i = 0; i < 8; ++i) { const int idx = tid + i * 512, row = idx >> 6, c4 = idx & 63; f32x4 x = v[i];
            if (d.gain) { const float gk = d.gain[d.kb * 64 + row]; x *= gk; }
            tile[row * 257 + c4 * 4 + 0] = x[0]; tile[row * 257 + c4 * 4 + 1] = x[1]; tile[row * 257 + c4 * 4 + 2] = x[2]; tile[row * 257 + c4 * 4 + 3] = x[3]; }
        __syncthreads();
#pragma unroll
        for (int i = 0; i < 4; ++i) { const int idx = tid + i * 512, col = idx >> 3, piece = idx & 7; float t[8];
#pragma unroll
            for (int k = 0; k < 8; ++k) t[k] = tile[(piece * 8 + k) * 257 + col];
            u32x4 w4; w4.x = cvt_pk_bf16(t[0], t[1]); w4.y = cvt_pk_bf16(t[2], t[3]); w4.z = cvt_pk_bf16(t[4], t[5]); w4.w = cvt_pk_bf16(t[6], t[7]);
            *(u32x4*)(d.Bt + (size_t)dest_row(d.kind, d.nb * 256 + col, d.NPART) * d.K + d.kb * 64 + piece * 8) = w4; }
        __syncthreads();
    } else {
        const int R = it - PO_NORM, wid = tid >> 6, lane = tid & 63; bf16_t* AP = (bf16_t*)(p.ws + WS_AP);
#pragma unroll
        for (int q = 0; q < 2; ++q) { const int s = wid * 2 + q; float ss = 0.f;
#pragma unroll
            for (int i = 0; i < 4; ++i) { const f32x4 x = v[q * 4 + i]; ss += (x[0] * x[0] + x[1] * x[1]) + (x[2] * x[2] + x[3] * x[3]); }
#pragma unroll
            for (int o = 32; o >= 1; o >>= 1) ss += __shfl_xor(ss, o);
            const float rs = rsqrtf(ss * (1.0f / DM) + RMS_EPS);
#pragma unroll
            for (int i = 0; i < 4; ++i) { const int c = i * 256 + lane * 4; const f32x4 gn = *(const f32x4*)(p.norm_mix + c); const f32x4 x = v[q * 4 + i];
                u32x2 w; w.x = cvt_pk_bf16(x[0] * rs * gn[0], x[1] * rs * gn[1]); w.y = cvt_pk_bf16(x[2] * rs * gn[2], x[3] * rs * gn[3]);
                *(u32x2*)(AP + ((size_t)(c >> 4) * NROW + R) * KA + s * 16 + (c & 15)) = w; } }
    }
}
__device__ __forceinline__ void run_items(const Params& p, int it0, int step, int end, LAS unsigned char* lds) {
    if (it0 >= end) return;
    f32x4 cur[8], nxt[8];
    item_load(p, it0, cur);
    for (int it = it0; it < end; it += step) {
        const bool more = it + step < end;
        if (more) item_load(p, it + step, nxt);
        item_finish(p, it, cur, lds);
        if (more) {
#pragma unroll
            for (int i = 0; i < 8; ++i) cur[i] = nxt[i]; }
    }
}

__device__ __forceinline__ void prep_phase(const Params& p, LAS unsigned char* lds) {
    const int G = gridDim.x, bid = blockIdx.x, tid = otid();
    { float* ssq = (float*)(p.ws + WS_SSQ); for (int i = bid * 512 + tid; i < 4 * MTOK; i += G * 512) ssq[i] = 0.f;
      bf16_t* WIN = (bf16_t*)(p.ws + WS_WIN);
      for (int i = bid * 512 + tid; i < 1024 * 128; i += G * 512) { const int zr = i >> 7, piece = i & 127;
          const int pn = zr >> 6, wc = (zr >> 4) & 3, rr = zr & 15; const int row = pn * 256 + 128 + 32 * wc + 16 + rr;
          *(u32x4*)(WIN + (size_t)row * 1024 + piece * 8) = (u32x4){0u, 0u, 0u, 0u}; } }
    int first = PI_S5;
    if (G > PI_S5) {
        if (bid < PI_S5) s5_precompute(p, bid, lds);
        else { const int e10 = PI_S5 + 13 * (G - PI_S5); run_items(p, PI_S5 + (bid - PI_S5), G - PI_S5, e10 < PI_ALL ? e10 : PI_ALL, lds); }
        first = PI_S5 + 13 * (G - PI_S5);
    } else for (int it = bid; it < PI_S5; it += G) s5_precompute(p, it, lds);
    run_items(p, first + bid, G, PI_ALL, lds);
}

__device__ __forceinline__ void scan_item(const Params& p, int g, int b, LAS unsigned char* lds) {
    LAS f32x2* E = (LAS f32x2*)lds;
    const int tid = otid(), pp = tid & 63, seg = __builtin_amdgcn_readfirstlane(tid >> 6);
    const float* S = (const float*)(p.ws + WS_S); bf16_t* AP = (bf16_t*)(p.ws + WS_AP);
    const float lr = p.a_re[g * 64 + pp], li = p.a_im[g * 64 + pp], dt = expf(p.log_dt[g]);
    f32x2 A16 = cpow_n(lr, li, dt, 16.f), A1k = cpow_n(lr, li, dt, 1024.f);
    const size_t row0 = (size_t)g * NROW + b * 512 + seg * 64;
    asm volatile("" : "+v"(A16), "+v"(A1k) :: "memory");
    const __amdgpu_buffer_rsrc_t rs = __builtin_amdgcn_make_buffer_rsrc((void*)(S + row0 * 128), (short)0, 0x7fffffff, 0x00020000);
    constexpr int NREG = 48;
    float sr[NREG], si[NREG], tr[64 - NREG], ti[64 - NREG];
#pragma unroll
    for (int c = 0; c < NREG; ++c) { sr[c] = __uint_as_float(__builtin_amdgcn_raw_buffer_load_b32(rs, pp * 4, c * 512, 0)); si[c] = __uint_as_float(__builtin_amdgcn_raw_buffer_load_b32(rs, pp * 4, c * 512 + 256, 0)); }
#pragma unroll
    for (int c = NREG; c < 64; ++c) { tr[c - NREG] = __uint_as_float(__builtin_amdgcn_raw_buffer_load_b32(rs, pp * 4, c * 512, 0)); ti[c - NREG] = __uint_as_float(__builtin_amdgcn_raw_buffer_load_b32(rs, pp * 4, c * 512 + 256, 0)); }
    float xr = 0.f, xi = 0.f;
#pragma unroll
    for (int c = 0; c < NREG; ++c) { const float nr = A16.x * xr - A16.y * xi + sr[c], ni = A16.x * xi + A16.y * xr + si[c]; xr = nr; xi = ni; }
#pragma unroll
    for (int c = NREG; c < 64; ++c) { const float nr = A16.x * xr - A16.y * xi + tr[c - NREG], ni = A16.x * xi + A16.y * xr + ti[c - NREG]; xr = nr; xi = ni; }
    E[seg * 64 + pp] = (f32x2){xr, xi};
    asm volatile("" ::: "memory");
#pragma unroll
    for (int c = NREG; c < 64; ++c) { tr[c - NREG] = __uint_as_float(__builtin_amdgcn_raw_buffer_load_b32(rs, pp * 4, c * 512, 0)); ti[c - NREG] = __uint_as_float(__builtin_amdgcn_raw_buffer_load_b32(rs, pp * 4, c * 512 + 256, 0)); }
    __syncthreads();
    xr = 0.f; xi = 0.f;
    for (int j = 0; j < seg; ++j) { const f32x2 e = E[j * 64 + pp]; const float nr = A1k.x * xr - A1k.y * xi + e.x, ni = A1k.x * xi + A1k.y * xr + e.y; xr = nr; xi = ni; }
    const __amdgpu_buffer_rsrc_t rd = __builtin_amdgcn_make_buffer_rsrc((void*)(AP + row0 * KA + 256), (short)0, 0x7fffffff, 0x00020000);
#pragma unroll
    for (int c = 0; c < 64; ++c) {
        __builtin_amdgcn_raw_buffer_store_b16((short)(cvt_pk_bf16(xr, xr) & 0xffffu), rd, pp * 2, c * (KA * 2), 0); __builtin_amdgcn_raw_buffer_store_b16((short)(cvt_pk_bf16(xi, xi) & 0xffffu), rd, pp * 2, c * (KA * 2) + 128, 0);
        const float a = c < NREG ? sr[c < NREG ? c : 0] : tr[c < NREG ? 0 : c - NREG], bq = c < NREG ? si[c < NREG ? c : 0] : ti[c < NREG ? 0 : c - NREG];
        const float nr = A16.x * xr - A16.y * xi + a, ni = A16.x * xi + A16.y * xr + bq; xr = nr; xi = ni; }
    __syncthreads();
}

template <int MODE, class Sched> __device__ __forceinline__ void fixup_local(const float* halo, const float* cw, const float* cb, bf16_t* out, int C, const Sched& S) {
    const int C4 = C >> 2, tid = otid(); Unit u;
    for (int i = 0; S.next(i, u); ++i)
        for (int c4 = tid; c4 < C4; c4 += 512) {
            const int c = c4 * 4;
            const f32x4 w0 = *(const f32x4*)(cw + c), w1 = *(const f32x4*)(cw + C + c), w2 = *(const f32x4*)(cw + 2 * C + c);
            f32x4 bb = (f32x4){0.f, 0.f, 0.f, 0.f}; if (MODE == 0) bb = *(const f32x4*)(cb + c);
            f32x4 t0[4], t1[4], h0[4], h1[4], y0[4], y1[4];
#pragma unroll
            for (int k = 0; k < 4; ++k) { const int s = 4 * u.pm + k; const float* hb = halo + (size_t)s * 6 * C + c; const bool first = (s & 127) == 0;
                const f32x4 z = (f32x4){0.f, 0.f, 0.f, 0.f};
                t0[k] = *(const f32x4*)(first ? hb : hb - (size_t)6 * C); t1[k] = *(const f32x4*)(first ? hb : hb - (size_t)5 * C);
                if (first) { t0[k] = z; t1[k] = z; }
                h0[k] = *(const f32x4*)(hb + (size_t)2 * C); h1[k] = *(const f32x4*)(hb + (size_t)3 * C);
                y0[k] = *(const f32x4*)(hb + (size_t)4 * C); y1[k] = *(const f32x4*)(hb + (size_t)5 * C); }
#pragma unroll
            for (int k = 0; k < 4; ++k) { const int s = 4 * u.pm + k; float o0[4], o1[4];
#pragma unroll
                for (int j = 0; j < 4; ++j) {
                    const float cv0 = w2[j] * h0[k][j] + w1[j] * t1[k][j] + w0[j] * t0[k][j] + bb[j];
                    const float cv1 = w2[j] * h1[k][j] + w1[j] * h0[k][j] + w0[j] * t1[k][j] + bb[j];
                    o0[j] = MODE == 0 ? silu_f(cv0) * y0[k][j] : cv0 * y0[k][j]; o1[j] = MODE == 0 ? silu_f(cv1) * y1[k][j] : cv1 * y1[k][j]; }
                u32x2 a; a.x = cvt_pk_bf16(o0[0], o0[1]); a.y = cvt_pk_bf16(o0[2], o0[3]); u32x2 b; b.x = cvt_pk_bf16(o1[0], o1[1]); b.y = cvt_pk_bf16(o1[2], o1[3]);
                *(u32x2*)(out + ((size_t)s * 64) * C + c) = a; *(u32x2*)(out + ((size_t)s * 64 + 1) * C + c) = b; }
        }
    asm volatile("s_waitcnt vmcnt(0)" ::: "memory");
    __syncthreads();
}

__device__ __forceinline__ void final_phase(float* out, const bf16_t* HB, const float* ssq, const float* gf) {
    for (int idx = blockIdx.x * 512 + otid(); idx < MTOK * 128; idx += gridDim.x * 512) {
        const int r = idx >> 7, c = (idx & 127) * 8;
        const float rs = rsqrtf(ssq[r] * (1.0f / DM) + RMS_EPS);
        const u32x4 q = __builtin_nontemporal_load((const u32x4*)(HB + (size_t)idx * 8)); const f32x4 g0 = *(const f32x4*)(gf + c), g1 = *(const f32x4*)(gf + c + 4);
        f32x4 v0 = (f32x4){bf_lo(q.x), bf_hi(q.x), bf_lo(q.y), bf_hi(q.y)}, v1 = (f32x4){bf_lo(q.z), bf_hi(q.z), bf_lo(q.w), bf_hi(q.w)};
        v0 *= g0 * rs; v1 *= g1 * rs;
        __builtin_nontemporal_store(v0, (f32x4*)(out + (size_t)idx * 8)); __builtin_nontemporal_store(v1, (f32x4*)(out + (size_t)idx * 8 + 4));
    }
}

__global__ void __launch_bounds__(512, 2) fwd_megakernel(Params p) {
    extern __shared__ __attribute__((aligned(16))) unsigned char smem[];
    LAS unsigned char* lds = (LAS unsigned char*)smem;
    unsigned* bar = (unsigned*)(p.ws + WS_CTL);
    volatile LAS unsigned* xst = (volatile LAS unsigned*)(lds + STAGE_BYTES);
    const unsigned xcc = xb_xcc_id();
    if (threadIdx.x == 0) { xst[0] = 0u; xst[1] = 0u; (void)xb_add(&bar[XB_XCNT(xcc)], 1u); }
    __syncthreads();
#define GRID_SYNC() grid_bar(bar, xcc, xst)
    float* ssq = (float*)(p.ws + WS_SSQ);
    bf16_t* AP = (bf16_t*)(p.ws + WS_AP); float* Sbuf = (float*)(p.ws + WS_S);
    bf16_t* Z = (bf16_t*)(p.ws + WS_Z); bf16_t* HB = (bf16_t*)(p.ws + WS_HB); bf16_t* ACT = (bf16_t*)(p.ws + WS_ACT);
    float* halo = (float*)(p.ws + WS_HALO);

    prep_phase(p, lds);
    if (p.ws == nullptr) cg::this_grid().sync();
    GRID_SYNC();
    for (int it = blockIdx.x; it < NG * 4; it += gridDim.x) {
        S5PairOrder S; S.init(it, 256); EpiS5a E{Sbuf}; gemm_phase<0>(lds, AP, KA, (const bf16_t*)(p.ws + WS_BTA), 256, S, E);
        asm volatile("s_waitcnt vmcnt(0)" ::: "memory"); __syncthreads();
        scan_item(p, it >> 2, it & 3, lds);
    }
    GRID_SYNC();
    { S5Order S; S.init(384); EpiS5b E{AP, p.s5_d, Z}; gemm_phase(lds, AP, KA, (const bf16_t*)(p.ws + WS_BTB), 384, S, E); }
    GRID_SYNC();
    { StdOrder S; S.init(MTOK, 2048, 1024, 1024); EpiGlu E{p.x, HB, ssq}; gemm_phase(lds, Z, 1024, (const bf16_t*)(p.ws + WS_WGLU), 1024, S, E); }
    GRID_SYNC();
    { StdOrder S; S.init(MTOK, 5632, 1024, 1024); EpiConv<0> E{ssq, p.ffn_conv_w, p.ffn_conv_b, ACT, halo, DFF}; gemm_phase(lds, HB, 1024, (const bf16_t*)(p.ws + WS_WUP0), 1024, S, E); }
    GRID_SYNC();
    { StdOrder S; S.init(MTOK, 1024, 2816, 2816); fixup_local<0>(halo, p.ffn_conv_w, p.ffn_conv_b, ACT, DFF, S); EpiRes<false> E{HB, ssq + MTOK}; gemm_phase(lds, ACT, 2816, (const bf16_t*)(p.ws + WS_WDN0), 2816, S, E); }
    GRID_SYNC();
    { StdOrder S; S.init(MTOK, 4096, 1024, 1024); EpiConv<1> E{ssq + MTOK, p.sc_conv, nullptr, Z, halo, DM}; gemm_phase<1>(lds, HB, 1024, (const bf16_t*)(p.ws + WS_WIN), 1024, S, E); }
    GRID_SYNC();
    { StdOrder S; S.init(MTOK, 1024, 1024, 1024); fixup_local<1>(halo, p.sc_conv, nullptr, Z, DM, S); EpiRes<false> E{HB, ssq + 2 * MTOK}; gemm_phase(lds, Z, 1024, (const bf16_t*)(p.ws + WS_WOUT), 1024, S, E); }
    GRID_SYNC();
    { StdOrder S; S.init(MTOK, 5632, 1024, 1024); EpiConv<0> E{ssq + 2 * MTOK, p.ffn_conv_w + 3 * DFF, p.ffn_conv_b + DFF, ACT, halo, DFF}; gemm_phase(lds, HB, 1024, (const bf16_t*)(p.ws + WS_WUP1), 1024, S, E); }
    GRID_SYNC();
    { StdOrder S; S.init(MTOK, 1024, 2816, 2816); fixup_local<0>(halo, p.ffn_conv_w + 3 * DFF, p.ffn_conv_b + DFF, ACT, DFF, S); EpiRes<true> E{HB, ssq + 3 * MTOK}; gemm_phase(lds, ACT, 2816, (const bf16_t*)(p.ws + WS_WDN1), 2816, S, E); }
    GRID_SYNC();
    final_phase(p.out, HB, ssq + 3 * MTOK, p.norm_final);
#undef GRID_SYNC
}

extern "C" void kernel_launch(void* const* d_in, const int* in_sizes, int n_in, void* d_out, int out_size, void* d_ws, size_t ws_size, hipStream_t stream) {
    constexpr int LDS_BYTES = STAGE_BYTES + 64 + 8192;
    static int grid = 0;
    if (grid == 0) {
        if (n_in != 20 || out_size != MTOK * DM || ws_size < WS_END) { fprintf(stderr, "kernel_launch: unexpected shapes (n_in %d out %d ws %zu need %zu)\n", n_in, out_size, ws_size, (size_t)WS_END); grid = -1; return; }
        int dev = 0, cus = 0, per_cu = 0;
        (void)hipGetDevice(&dev); (void)hipDeviceGetAttribute(&cus, hipDeviceAttributeMultiprocessorCount, dev);
        if (hipFuncSetAttribute((const void*)fwd_megakernel, hipFuncAttributeMaxDynamicSharedMemorySize, LDS_BYTES) != hipSuccess) { fprintf(stderr, "kernel_launch: hipFuncSetAttribute failed\n"); grid = -1; return; }
        (void)hipOccupancyMaxActiveBlocksPerMultiprocessor(&per_cu, (const void*)fwd_megakernel, 512, LDS_BYTES);
        if (per_cu < 1) { fprintf(stderr, "kernel_launch: occupancy query says %d blocks per CU\n", per_cu); per_cu = 1; }
        (void)hipGetLastError();
        grid = cus;
    }
    if (grid < 0) return;
    (void)hipMemsetAsync((char*)d_ws + WS_CTL, 0, 16384, stream);
    Params p{};
    p.x = (const float*)d_in[0]; p.norm_mix = (const float*)d_in[1]; p.norm_ffn = (const float*)d_in[2]; p.norm_final = (const float*)d_in[3];
    p.a_re = (const float*)d_in[4]; p.a_im = (const float*)d_in[5]; p.log_dt = (const float*)d_in[6]; p.b_re = (const float*)d_in[7]; p.b_im = (const float*)d_in[8];
    p.c_re = (const float*)d_in[9]; p.c_im = (const float*)d_in[10]; p.s5_d = (const float*)d_in[11]; p.w_glu = (const float*)d_in[12];
    p.w_in = (const float*)d_in[13]; p.sc_conv = (const float*)d_in[14]; p.w_out = (const float*)d_in[15];
    p.w_up = (const float*)d_in[16]; p.ffn_conv_w = (const float*)d_in[17]; p.ffn_conv_b = (const float*)d_in[18]; p.w_down = (const float*)d_in[19];
    p.out = (float*)d_out; p.ws = (unsigned char*)d_ws;
    void* args[] = {&p};
    hipError_t e = hipLaunchCooperativeKernel((const void*)fwd_megakernel, dim3(grid), dim3(512), args, LDS_BYTES, stream);
    if (e != hipSuccess) fprintf(stderr, "cooperative launch failed: %s (grid %d)\n", hipGetErrorString(e), grid);
}
```

```cpp
#include <hip/hip_runtime.h>
#include <hip/hip_cooperative_groups.h>
#include <cstdio>
namespace cg = cooperative_groups;

#define LAS __attribute__((address_space(3)))
typedef unsigned short bf16_t;
typedef short bf16x8 __attribute__((ext_vector_type(8)));
typedef float f32x4 __attribute__((ext_vector_type(4)));
typedef float f32x2 __attribute__((ext_vector_type(2)));
typedef unsigned u32x4 __attribute__((ext_vector_type(4)));
typedef unsigned u32x2 __attribute__((ext_vector_type(2)));

constexpr int MTOK = 32768, DM = 1024, DFF = 2816, NG = 64, NP = 64, NROW = 2048  , KA = 384  ;
constexpr float RMS_EPS = 1e-6f;

constexpr size_t WS_CTL   = 0;
constexpr size_t WS_SSQ   = 16384;
constexpr size_t WS_WGLU  = WS_SSQ + 4ull * MTOK * 4;
constexpr size_t WS_WUP0  = WS_WGLU + 2048ull * 1024 * 2;
constexpr size_t WS_WUP1  = WS_WUP0 + 5632ull * 1024 * 2;
constexpr size_t WS_WDN0  = WS_WUP1 + 5632ull * 1024 * 2;
constexpr size_t WS_WDN1  = WS_WDN0 + 1024ull * 2816 * 2;
constexpr size_t WS_WIN   = WS_WDN1 + 1024ull * 2816 * 2;
constexpr size_t WS_WOUT  = WS_WIN + 4096ull * 1024 * 2;
constexpr size_t WS_BTA   = WS_WOUT + 1024ull * 1024 * 2;
constexpr size_t WS_BTB   = WS_BTA + 64ull * 256 * 256 * 2;
constexpr size_t WS_Z     = WS_BTB + 64ull * 256 * 384 * 2;
constexpr size_t WS_HB    = WS_Z + (size_t)MTOK * 1024 * 2;
constexpr size_t WS_HALO  = WS_HB + (size_t)MTOK * 1024 * 2;
constexpr size_t WS_R1    = WS_HALO + 512ull * 6 * 2816 * 4;
constexpr size_t WS_AP    = WS_R1;
constexpr size_t WS_S     = WS_AP + 64ull * 2048 * 384 * 2;
constexpr size_t WS_ACT   = WS_R1;
constexpr size_t WS_R1_SZ = (64ull * 2048 * 384 * 2 + 64ull * 2048 * 128 * 4) > ((size_t)MTOK * 2816 * 2) ? (64ull * 2048 * 384 * 2 + 64ull * 2048 * 128 * 4) : ((size_t)MTOK * 2816 * 2);
constexpr size_t WS_END   = WS_R1 + WS_R1_SZ;

__device__ __forceinline__ unsigned cvt_pk_bf16(float lo, float hi) { unsigned r; asm volatile("v_cvt_pk_bf16_f32 %0, %1, %2" : "=v"(r) : "v"(lo), "v"(hi)); return r; }
__device__ __forceinline__ float bf_lo(unsigned w) { return __uint_as_float(w << 16); }
__device__ __forceinline__ float bf_hi(unsigned w) { return __uint_as_float(w & 0xffff0000u); }
__device__ __forceinline__ float fast_sigmoid(float x) { return __builtin_amdgcn_rcpf(1.0f + __builtin_amdgcn_exp2f(x * -1.44269504f)); }
__device__ __forceinline__ float gelu_tanh(float y) { const float t = y * (-2.302208198f + -0.1029432397f * (y * y)); return y * __builtin_amdgcn_rcpf(1.0f + __builtin_amdgcn_exp2f(t)); }
__device__ __forceinline__ float silu_f(float x) { return x * __builtin_amdgcn_rcpf(1.0f + __builtin_amdgcn_exp2f(x * -1.44269504f)); }
template <int CTRL> __device__ __forceinline__ float dpp_mov(float old, float x) { return __int_as_float(__builtin_amdgcn_update_dpp(__float_as_int(old), __float_as_int(x), CTRL, 0xf, 0xf, false)); }
__device__ __forceinline__ int otid() { int t = threadIdx.x; asm volatile("" : "+v"(t)); return t; }
#define XB_XCNT(j)  (256  + 64 * (j))
#define XB_XSUB(j)  (1280 + 64 * (j))
#define XB_XGEN(j)  (2304 + 64 * (j))
#define XB_TOP      3328
#define XB_TOPGEN   3392
#define XCD_BAR_WORDS 3456
__device__ __forceinline__ unsigned xb_ld(unsigned* p)              { return __hip_atomic_load(p, __ATOMIC_RELAXED, __HIP_MEMORY_SCOPE_AGENT); }
__device__ __forceinline__ unsigned xb_add(unsigned* p, unsigned v) { return __hip_atomic_fetch_add(p, v, __ATOMIC_RELAXED, __HIP_MEMORY_SCOPE_AGENT); }
__device__ __forceinline__ unsigned xb_xcc_id() { return (unsigned)__builtin_amdgcn_s_getreg((3 << 11) | 20) & 0xFu; }
__device__ __forceinline__ void xb_complete(unsigned* bar, unsigned x, unsigned& nloc, unsigned& nx) {
    const unsigned G = gridDim.x; unsigned sum, cnt, mine;
    for (;;) { sum = 0u; cnt = 0u; mine = 0u;
#pragma unroll
        for (unsigned j = 0; j < 16; ++j) { const unsigned c = xb_ld(&bar[XB_XCNT(j)]); sum += c; cnt += (c > 0u) ? 1u : 0u; mine = (j == x) ? c : mine; }
        if (sum == G) break;
        __builtin_amdgcn_s_sleep(1); }
    nloc = mine > 0u ? mine : 1u; nx = cnt > 0u ? cnt : 1u;
}
__device__ __forceinline__ void grid_bar(unsigned* bar, unsigned x, volatile LAS unsigned* st) {
    asm volatile("s_waitcnt vmcnt(0) lgkmcnt(0)" ::: "memory");
    __syncthreads();
    if (threadIdx.x == 0) {
        __builtin_amdgcn_s_waitcnt(0);
        unsigned nloc = st[0], nx = st[1];
        if (nloc == 0u) { xb_complete(bar, x, nloc, nx); st[0] = nloc; st[1] = nx; }
        const unsigned old = xb_add(&bar[XB_XSUB(x)], 1u);
        const unsigned gen = old / nloc;
        if (old + 1u == (gen + 1u) * nloc) {
            __builtin_amdgcn_fence(__ATOMIC_RELEASE, "agent");
            asm volatile("s_waitcnt vmcnt(0)" ::: "memory");
            const unsigned og = xb_add(&bar[XB_TOP], 1u);
            const unsigned tg = og / nx;
            if (og + 1u == (tg + 1u) * nx) xb_add(&bar[XB_TOPGEN], 1u);
            else while (xb_ld(&bar[XB_TOPGEN]) == tg) __builtin_amdgcn_s_sleep(1);
            __builtin_amdgcn_fence(__ATOMIC_ACQUIRE, "agent");
            xb_add(&bar[XB_XGEN(x)], 1u);
            asm volatile("s_waitcnt vmcnt(0)" ::: "memory");
        } else {
            while (xb_ld(&bar[XB_XGEN(x)]) == gen) __builtin_amdgcn_s_sleep(1);
            __builtin_amdgcn_fence(__ATOMIC_ACQUIRE, "agent");
            asm volatile("s_waitcnt vmcnt(0)" ::: "memory");
        }
    }
    __syncthreads();
}

constexpr int BM = 256, BK = 64, HALF = 128, HTB = HALF * BK * 2, STAGE_BYTES = 8 * HTB, NXCD = 8, WGM = 8;
__device__ __forceinline__ int lds_byte(int r, int c) { const int st = (r >> 4) * 2 + (c >> 5), rr = r & 15, cc = c & 31, ob = rr * 64 + cc * 2; return st * 1024 + (ob ^ (((ob >> 9) & 1) << 5)); }
__device__ __forceinline__ void stage_rc(int b, int& R, int& C) { const int st = b / 1024, sb = b % 1024, swz = sb ^ (((sb >> 9) & 1) << 5); R = (st >> 1) * 16 + swz / 64; C = (st & 1) * 32 + (swz % 64) / 2; }

struct Unit { int pm, pn, g; };
struct StdOrder {
    int nM, nN, nwg, G, c; size_t atile, btile;
    __device__ __forceinline__ void init(int M, int N, int lda, int K) { nM = M / BM; nN = N / BM; nwg = nM * nN; G = gridDim.x; c = blockIdx.x; asm volatile("" : "+s"(c), "+s"(nN));     atile = (size_t)BM * lda * 2; btile = (size_t)BM * K * 2; }
    __device__ __forceinline__ bool next(int i, Unit& u) const {
        const long L = (long)i * G + c; if (L >= nwg) return false;
        int wgid = (int)L; { const int q = nwg / NXCD, r = nwg % NXCD, xcd = wgid % NXCD, off = wgid / NXCD; wgid = (xcd < r ? xcd * (q + 1) : r * (q + 1) + (xcd - r) * q) + off; }
        const int nig = WGM * nN, gid = wgid / nig, fm = gid * WGM, gsz = (nM - fm) < WGM ? (nM - fm) : WGM;
        u.pm = __builtin_amdgcn_readfirstlane(fm + ((wgid % nig) % gsz)); u.pn = __builtin_amdgcn_readfirstlane((wgid % nig) / gsz); u.g = 0; return true;
    }
    __device__ __forceinline__ size_t a_off(const Unit& u) const { return (size_t)u.pm * atile; }
    __device__ __forceinline__ size_t b_off(const Unit& u) const { return (size_t)u.pn * btile; }
};
struct S5Order {
    int G, c; size_t btile;
    __device__ __forceinline__ void init(int K) { G = gridDim.x; c = blockIdx.x; asm volatile("" : "+s"(c)); btile = (size_t)BM * K * 2; }
    __device__ __forceinline__ bool next(int i, Unit& u) const { const long L = (long)i * G + c; if (L >= NG * 8) return false; u.g = (int)(L >> 3); u.pm = (int)(L & 7); u.pn = 0; return true; }
    __device__ __forceinline__ size_t a_off(const Unit& u) const { return ((size_t)u.g * NROW + (size_t)u.pm * BM) * KA * 2; }
    __device__ __forceinline__ size_t b_off(const Unit& u) const { return (size_t)u.g * btile; }
};

struct S5PairOrder {
    int g, b; size_t btile;
    __device__ __forceinline__ void init(int it, int K) { g = it >> 2; b = it & 3; btile = (size_t)BM * K * 2; }
    __device__ __forceinline__ bool next(int i, Unit& u) const { if (i >= 2) return false; u.g = g; u.pm = 2 * b + i; u.pn = 0; return true; }
    __device__ __forceinline__ size_t a_off(const Unit& u) const { return ((size_t)u.g * NROW + (size_t)u.pm * BM) * KA * 2; }
    __device__ __forceinline__ size_t b_off(const Unit& u) const { return (size_t)u.g * btile; }
};

template <int NB1 = 2, class Epi, class Sched>
__device__ __forceinline__ void gemm_phase(LAS unsigned char* lds, const bf16_t* Ap, int lda, const bf16_t* Btp, int K, const Sched& S, const Epi& E) {
    int tid_ = threadIdx.x; asm volatile("" : "+v"(tid_));
    const int tid = tid_, wid = __builtin_amdgcn_readfirstlane(tid >> 6), lane = tid & 63, wr = wid >> 2, wc = wid & 3, fr = lane & 15, fq = lane >> 4;
    asm volatile("" : "+s"(K), "+s"(lda));
    const int nt = K / BK;
    unsigned voffA[2], voffB[2];
#pragma unroll
    for (int i = 0; i < 2; ++i) { int R, C; stage_rc(tid * 16 + i * 8192, R, C); voffA[i] = (unsigned)(R * lda + C) * 2u; voffB[i] = (unsigned)(R * K + C) * 2u; }
    const size_t kstep = (size_t)(BK * 2);
    const size_t hstepA = (size_t)HALF * lda * 2, hstepB = (size_t)HALF * K * 2;
    const unsigned ldsw = (unsigned)wid * 1024u;
    const int aoff = lds_byte(wr * 64 + fr, fq * 8), boff = lds_byte(wc * 32 + fr, fq * 8);
#define PG8_SA(b, h) (((b) * 2 + (h)) * HTB)
#define PG8_SB(b, h) ((4 + (b) * 2 + (h)) * HTB)
#define PG8_STAGE(bufoff, gbase, voff) do { const __amdgpu_buffer_rsrc_t _r = __builtin_amdgcn_make_buffer_rsrc((void*)(gbase), (short)0, 0x7fffffff, 0x00020000); _Pragma("unroll") for (int _i = 0; _i < 2; ++_i) \
        __builtin_amdgcn_raw_ptr_buffer_load_lds(_r, (LAS unsigned*)(lds + (bufoff) + ldsw + _i * 8192), 16, (int)(voff)[_i], 0, 0, 0); } while (0)
#define PG8_LDA(dst, b, h) do { _Pragma("unroll") for (int m = 0; m < 4; ++m) _Pragma("unroll") for (int k = 0; k < 2; ++k) dst[m][k] = *(const LAS bf16x8*)(lds + PG8_SA(b, h) + aoff + m * 2048 + k * 1024); } while (0)
#define PG8_LDB(dst, b, h) do { _Pragma("unroll") for (int n = 0; n < 2; ++n) _Pragma("unroll") for (int k = 0; k < 2; ++k) dst[n][k] = *(const LAS bf16x8*)(lds + PG8_SB(b, h) + boff + n * 2048 + k * 1024); } while (0)
#define PG8_MMA(ai, bj, At, Bt) do { __builtin_amdgcn_s_setprio(1); _Pragma("unroll") for (int k = 0; k < 2; ++k) _Pragma("unroll") for (int m = 0; m < 4; ++m) _Pragma("unroll") for (int n = 0; n < ((bj) == 1 ? NB1 : 2); ++n) \
        acc[ai][bj][m][n] = __builtin_amdgcn_mfma_f32_16x16x32_bf16(Bt[n][k], At[m][k], acc[ai][bj][m][n], 0, 0, 0); __builtin_amdgcn_s_setprio(0); } while (0)
#define PG8_WAIT_V(n) asm volatile("s_waitcnt vmcnt(" #n ")" ::: "memory")
#define PG8_WAIT_L(n) asm volatile("s_waitcnt lgkmcnt(" #n ")" ::: "memory")
#define PG8_BAR __builtin_amdgcn_s_barrier()
#define PG8_SCHED __builtin_amdgcn_sched_barrier(0)
    Unit cur, nxt; int ui = 0;
    if (!S.next(0, cur)) return;
    f32x4 epar = E.prefetch(cur, wr, wc, lane);
    f32x4 acc[2][2][4][2];
#pragma unroll
    for (int a = 0; a < 2; ++a)
#pragma unroll
        for (int b = 0; b < 2; ++b)
#pragma unroll
            for (int m = 0; m < 4; ++m)
#pragma unroll
                for (int n = 0; n < 2; ++n) acc[a][b][m][n] = (f32x4){0.f, 0.f, 0.f, 0.f};
    bf16x8 At[4][2], B0[2][2], B1[2][2];
    const char* cA = (const char*)Ap + S.a_off(cur); const char* cB = (const char*)Btp + S.b_off(cur);
    PG8_STAGE(PG8_SB(0, 0), cB, voffB); PG8_STAGE(PG8_SA(0, 0), cA, voffA); PG8_STAGE(PG8_SB(0, 1), cB + hstepB, voffB); PG8_STAGE(PG8_SA(0, 1), cA + hstepA, voffA);
    if (wr == 1) PG8_BAR;
    PG8_WAIT_V(4); PG8_BAR;
    PG8_STAGE(PG8_SB(1, 0), cB + kstep, voffB); PG8_STAGE(PG8_SA(1, 0), cA + kstep, voffA); PG8_STAGE(PG8_SB(1, 1), cB + hstepB + kstep, voffB);
    PG8_WAIT_V(6); PG8_BAR;
    for (;;) {
        const bool has_next = S.next(ui + 1, nxt);
        const char* nA = has_next ? (const char*)Ap + S.a_off(nxt) : cA; const char* nB = has_next ? (const char*)Btp + S.b_off(nxt) : cB;
        for (int t = 0; t < nt; t += 2) {
            const bool last = (t == nt - 2);
            const char* a1 = cA + (size_t)(t + 1) * kstep;
            const char* a2 = last ? nA : cA + (size_t)(t + 2) * kstep; const char* b2 = last ? nB : cB + (size_t)(t + 2) * kstep;
            const char* a3 = a2 + kstep; const char* b3 = b2 + kstep;
            PG8_LDB(B0, 0, 0); PG8_SCHED; PG8_LDA(At, 0, 0); PG8_STAGE(PG8_SA(1, 1), a1 + hstepA, voffA);
            PG8_WAIT_L(8); PG8_BAR; PG8_WAIT_L(0); PG8_MMA(0, 0, At, B0); PG8_BAR; PG8_SCHED;
            PG8_LDB(B1, 0, 1); PG8_STAGE(PG8_SB(0, 0), b2, voffB);
            PG8_BAR; PG8_WAIT_L(0); PG8_MMA(0, 1, At, B1); PG8_BAR;
            PG8_LDA(At, 0, 1); PG8_STAGE(PG8_SA(0, 0), a2, voffA);
            PG8_BAR; PG8_WAIT_L(0); PG8_MMA(1, 0, At, B0); PG8_BAR; PG8_SCHED;
            PG8_STAGE(PG8_SB(0, 1), b2 + hstepB, voffB);
            PG8_WAIT_V(6); PG8_BAR; PG8_MMA(1, 1, At, B1); PG8_BAR;
            PG8_LDB(B0, 1, 0); PG8_SCHED; PG8_LDA(At, 1, 0); PG8_STAGE(PG8_SA(0, 1), a2 + hstepA, voffA);
            PG8_WAIT_L(8); PG8_BAR; PG8_WAIT_L(0); PG8_MMA(0, 0, At, B0); PG8_BAR; PG8_SCHED;
            PG8_LDB(B1, 1, 1); PG8_STAGE(PG8_SB(1, 0), b3, voffB);
            PG8_BAR; PG8_WAIT_L(0); PG8_MMA(0, 1, At, B1); PG8_BAR;
            PG8_LDA(At, 1, 1); PG8_STAGE(PG8_SA(1, 0), a3, voffA);
            PG8_BAR; PG8_WAIT_L(0); PG8_MMA(1, 0, At, B0); PG8_BAR; PG8_SCHED;
            PG8_STAGE(PG8_SB(1, 1), b3 + hstepB, voffB);
            PG8_WAIT_V(6); PG8_BAR; PG8_MMA(1, 1, At, B1); PG8_BAR;
        }
        E(acc, cur, wr, wc, fr, fq, lds, epar);
        if (has_next) epar = E.prefetch(nxt, wr, wc, lane);
        if (!has_next) break;
#pragma unroll
        for (int a = 0; a < 2; ++a)
#pragma unroll
            for (int b = 0; b < 2; ++b)
#pragma unroll
                for (int m = 0; m < 4; ++m)
#pragma unroll
                    for (int n = 0; n < 2; ++n) acc[a][b][m][n] = (f32x4){0.f, 0.f, 0.f, 0.f};
        cur = nxt; cA = nA; cB = nB; ++ui;
    }
    PG8_WAIT_V(0);
    if (wr == 0) PG8_BAR;
    PG8_BAR;
#undef PG8_SA
#undef PG8_SB
#undef PG8_STAGE
#undef PG8_LDA
#undef PG8_LDB
#undef PG8_MMA
#undef PG8_WAIT_V
#undef PG8_WAIT_L
#undef PG8_BAR
#undef PG8_SCHED
}

typedef f32x4 Acc[2][2][4][2];

struct EpiS5a {
    __device__ __forceinline__ f32x4 prefetch(const Unit&, int, int, int) const { return (f32x4){0.f, 0.f, 0.f, 0.f}; }
    float* S;
    __device__ __forceinline__ void operator()(const Acc& acc, const Unit& u, int wr, int wc, int fr, int fq, LAS unsigned char* lds, f32x4 epar) const {
        const int row0 = u.g * NROW + u.pm * BM + wr * 64 + fr, col0 = wc * 32 + 4 * fq;
#pragma unroll
        for (int ai = 0; ai < 2; ++ai)
#pragma unroll
            for (int m = 0; m < 4; ++m) { float* rowp = S + (size_t)(row0 + ai * HALF + m * 16) * 128 + col0;
#pragma unroll
                for (int n = 0; n < 2; ++n) *(f32x4*)(rowp + n * 16) = acc[ai][0][m][n]; }
    }
};
struct EpiS5b {
    __device__ __forceinline__ f32x4 prefetch(const Unit&, int, int, int) const { return (f32x4){0.f, 0.f, 0.f, 0.f}; }
    const bf16_t* AP; const float* dskip; bf16_t* Z;
    __device__ __forceinline__ void operator()(const Acc& acc, const Unit& u, int wr, int wc, int fr, int fq, LAS unsigned char* lds, f32x4 epar) const {
        const int h0 = 8 * (fq & 1);
        const f32x4 d0 = *(const f32x4*)(dskip + u.g * 16 + h0), d1 = *(const f32x4*)(dskip + u.g * 16 + h0 + 4);
        u32x4 uu[2][4][2];
#pragma unroll
        for (int ai = 0; ai < 2; ++ai)
#pragma unroll
            for (int m = 0; m < 4; ++m) { const int Rg = u.pm * BM + ai * HALF + wr * 64 + m * 16 + fr;
#pragma unroll
                for (int bj = 0; bj < 2; ++bj) { const int t = 8 * bj + 2 * wc + (fq >> 1); uu[ai][m][bj] = *(const u32x4*)(AP + ((size_t)u.g * NROW + Rg) * KA + t * 16 + h0); } }
#pragma unroll
        for (int ai = 0; ai < 2; ++ai)
#pragma unroll
            for (int m = 0; m < 4; ++m) { const int Rg = u.pm * BM + ai * HALF + wr * 64 + m * 16 + fr;
#pragma unroll
                for (int bj = 0; bj < 2; ++bj) { const int t = 8 * bj + 2 * wc + (fq >> 1);
                    const u32x4 q = uu[ai][m][bj];
                    const f32x4 a0 = acc[ai][bj][m][0], a1 = acc[ai][bj][m][1];
                    float y[8];
                    y[0] = a0[0] + d0[0] * bf_lo(q.x); y[1] = a0[1] + d0[1] * bf_hi(q.x); y[2] = a0[2] + d0[2] * bf_lo(q.y); y[3] = a0[3] + d0[3] * bf_hi(q.y);
                    y[4] = a1[0] + d1[0] * bf_lo(q.z); y[5] = a1[1] + d1[1] * bf_hi(q.z); y[6] = a1[2] + d1[2] * bf_lo(q.w); y[7] = a1[3] + d1[3] * bf_hi(q.w);
#pragma unroll
                    for (int i = 0; i < 8; ++i) y[i] = gelu_tanh(y[i]);
                    u32x4 w; w.x = cvt_pk_bf16(y[0], y[1]); w.y = cvt_pk_bf16(y[2], y[3]); w.z = cvt_pk_bf16(y[4], y[5]); w.w = cvt_pk_bf16(y[6], y[7]);
                    *(u32x4*)(Z + ((size_t)Rg * 16 + t) * DM + u.g * 16 + h0) = w; } }
    }
};
struct EpiGlu {
    __device__ __forceinline__ f32x4 prefetch(const Unit&, int, int, int) const { return (f32x4){0.f, 0.f, 0.f, 0.f}; }
    const float* x; bf16_t* HB; float* ssq;
    __device__ __forceinline__ void operator()(const Acc& acc, const Unit& u, int wr, int wc, int fr, int fq, LAS unsigned char* lds, f32x4 epar) const {
        const int c0 = u.pn * 128 + wc * 32 + 8 * fq;
        f32x4 xv[2][4][2];
#pragma unroll
        for (int ai = 0; ai < 2; ++ai)
#pragma unroll
            for (int m = 0; m < 4; ++m) { const int r = u.pm * BM + ai * HALF + wr * 64 + m * 16 + fr; const size_t off = (size_t)r * DM + c0;
                xv[ai][m][0] = __builtin_nontemporal_load((const f32x4*)(x + off)); xv[ai][m][1] = __builtin_nontemporal_load((const f32x4*)(x + off + 4)); }
#pragma unroll
        for (int ai = 0; ai < 2; ++ai)
#pragma unroll
            for (int m = 0; m < 4; ++m) { const int r = u.pm * BM + ai * HALF + wr * 64 + m * 16 + fr; const size_t off = (size_t)r * DM + c0;
                f32x4 v0 = xv[ai][m][0], v1 = xv[ai][m][1];
                const f32x4 za0 = acc[ai][0][m][0], za1 = acc[ai][0][m][1], zg0 = acc[ai][1][m][0], zg1 = acc[ai][1][m][1];
#pragma unroll
                for (int j = 0; j < 4; ++j) { v0[j] += za0[j] * fast_sigmoid(zg0[j]); v1[j] += za1[j] * fast_sigmoid(zg1[j]); }
                u32x4 w; w.x = cvt_pk_bf16(v0[0], v0[1]); w.y = cvt_pk_bf16(v0[2], v0[3]); w.z = cvt_pk_bf16(v1[0], v1[1]); w.w = cvt_pk_bf16(v1[2], v1[3]);
                *(u32x4*)(HB + off) = w;
                float s = (v0[0] * v0[0] + v0[1] * v0[1]) + (v0[2] * v0[2] + v0[3] * v0[3]) + (v1[0] * v1[0] + v1[1] * v1[1]) + (v1[2] * v1[2] + v1[3] * v1[3]);
                s += __shfl_xor(s, 16); s += __shfl_xor(s, 32);
                if (fq == 0) unsafeAtomicAdd(ssq + r, s); }
    }
};
template <bool LAST> struct EpiRes {
    __device__ __forceinline__ f32x4 prefetch(const Unit&, int, int, int) const { return (f32x4){0.f, 0.f, 0.f, 0.f}; }
    bf16_t* HB; float* ssq;
    __device__ __forceinline__ void operator()(const Acc& acc, const Unit& u, int wr, int wc, int fr, int fq, LAS unsigned char* lds, f32x4 epar) const {
        u32x4 hv[2][4][2];
#pragma unroll
        for (int ai = 0; ai < 2; ++ai)
#pragma unroll
            for (int m = 0; m < 4; ++m) { const int r = u.pm * BM + ai * HALF + wr * 64 + m * 16 + fr;
#pragma unroll
                for (int bj = 0; bj < 2; ++bj) hv[ai][m][bj] = *(const u32x4*)(HB + (size_t)r * DM + u.pn * 256 + bj * 128 + wc * 32 + 8 * fq); }
#pragma unroll
        for (int ai = 0; ai < 2; ++ai)
#pragma unroll
            for (int m = 0; m < 4; ++m) { const int r = u.pm * BM + ai * HALF + wr * 64 + m * 16 + fr; float s = 0.f;
#pragma unroll
                for (int bj = 0; bj < 2; ++bj) { const size_t off = (size_t)r * DM + u.pn * 256 + bj * 128 + wc * 32 + 8 * fq;
                    const u32x4 q = hv[ai][m][bj];
                    f32x4 v0 = (f32x4){bf_lo(q.x), bf_hi(q.x), bf_lo(q.y), bf_hi(q.y)}, v1 = (f32x4){bf_lo(q.z), bf_hi(q.z), bf_lo(q.w), bf_hi(q.w)};
                    v0 += acc[ai][bj][m][0]; v1 += acc[ai][bj][m][1];
                    u32x4 w; w.x = cvt_pk_bf16(v0[0], v0[1]); w.y = cvt_pk_bf16(v0[2], v0[3]); w.z = cvt_pk_bf16(v1[0], v1[1]); w.w = cvt_pk_bf16(v1[2], v1[3]);
                    *(u32x4*)(HB + off) = w;
                    s += (v0[0] * v0[0] + v0[1] * v0[1]) + (v0[2] * v0[2] + v0[3] * v0[3]) + (v1[0] * v1[0] + v1[1] * v1[1]) + (v1[2] * v1[2] + v1[3] * v1[3]); }
                s += __shfl_xor(s, 16); s += __shfl_xor(s, 32);
                if (fq == 0) unsafeAtomicAdd(ssq + r, s); }
    }
};
template <int MODE> struct EpiConv {
    const float* ssq; const float* cw; const float* cb; bf16_t* out; bf16_t* halo; int C;
    __device__ __forceinline__ f32x4 prefetch(const Unit& u, int wr, int wc, int lane) const {
        const float* ptr;
        if (lane < 32) { const int arr = lane >> 3, j = lane & 7;
            if (MODE == 0) ptr = (arr < 3 ? cw + arr * C : cb) + u.pn * 128 + wc * 32 + 4 * j;
            else ptr = cw + (arr < 3 ? arr : 0) * C + u.pn * 64 + wc * 16 + 4 * (j & 3); }
        else { const int k = lane - 32; ptr = ssq + u.pm * BM + (k >> 4) * HALF + wr * 64 + 4 * (k & 15); }
        f32x4 v; asm volatile("global_load_dwordx4 %0, %1, off" : "=&v"(v) : "v"(ptr) : "memory"); return v;
    }
    __device__ __forceinline__ void operator()(const Acc& acc, const Unit& u, int wr, int wc, int fr, int fq, LAS unsigned char* lds, f32x4 epar) const {
        constexpr int NV = MODE == 0 ? 8 : 4;
        const int c0 = MODE == 0 ? (u.pn * 128 + wc * 32 + 8 * fq) : (u.pn * 64 + wc * 16 + 4 * fq);
        LAS float* pw = (LAS float*)(lds + STAGE_BYTES + 64 + (wr * 4 + wc) * 1024);
        *(LAS f32x4*)(pw + (fq * 16 + fr) * 4) = epar;
        asm volatile("s_waitcnt lgkmcnt(0)" ::: "memory");
        float w0[NV], w1[NV], w2[NV], bb[NV];
#pragma unroll
        for (int i = 0; i < NV; i += 4) { const f32x4 a = *(const LAS f32x4*)(pw + NV * fq + i), b = *(const LAS f32x4*)(pw + 32 + NV * fq + i), c = *(const LAS f32x4*)(pw + 64 + NV * fq + i);
            f32x4 d = (f32x4){0.f, 0.f, 0.f, 0.f}; if (MODE == 0) d = *(const LAS f32x4*)(pw + 96 + NV * fq + i);
#pragma unroll
            for (int j = 0; j < 4; ++j) { w0[i + j] = a[j]; w1[i + j] = b[j]; w2[i + j] = c[j]; bb[i + j] = d[j]; } }
        float sq[2][4];
#pragma unroll
        for (int ai = 0; ai < 2; ++ai)
#pragma unroll
            for (int m = 0; m < 4; ++m) sq[ai][m] = pw[128 + ai * 64 + m * 16 + fr];
#pragma unroll
        for (int ai = 0; ai < 2; ++ai) {
            const int strip = u.pm * 4 + ai * 2 + wr;
            float p1prev[NV], p2prev[NV];
#pragma unroll
            for (int i = 0; i < NV; ++i) { p1prev[i] = 0.f; p2prev[i] = 0.f; }
#pragma unroll
            for (int m = 0; m < 4; ++m) {
                const int r = u.pm * BM + ai * HALF + wr * 64 + m * 16 + fr;
                const float rs = __builtin_amdgcn_rsqf(sq[ai][m] * (1.0f / DM) + RMS_EPS);
                float X[NV], Y[NV], o[NV];
                if (MODE == 0) {
#pragma unroll
                    for (int n = 0; n < 2; ++n)
#pragma unroll
                        for (int j = 0; j < 4; ++j) { X[n * 4 + j] = acc[ai][0][m][n][j] * rs; Y[n * 4 + j] = acc[ai][1][m][n][j] * rs; }
                } else {
#pragma unroll
                    for (int j = 0; j < 4; ++j) { X[j] = (acc[ai][0][m][1][j] * rs) * (acc[ai][1][m][0][j] * rs); Y[j] = acc[ai][0][m][0][j] * rs; }
                }
#pragma unroll
                for (int i = 0; i < NV; ++i) {
                    const float q1 = dpp_mov<0x111>(p1prev[i], X[i]), q2 = dpp_mov<0x112>(p2prev[i], X[i]);
                    p1prev[i] = dpp_mov<0x121>(0.f, X[i]); p2prev[i] = dpp_mov<0x122>(0.f, X[i]);
                    const float cv = w2[i] * X[i] + w1[i] * q1 + w0[i] * q2 + bb[i];
                    o[i] = MODE == 0 ? silu_f(cv) * Y[i] : cv * Y[i];
                }
                if (m == 0 && fr < 2) {
                    bf16_t* hx = halo + ((size_t)strip * 6 + 2 + fr) * C + c0; bf16_t* hy = halo + ((size_t)strip * 6 + 4 + fr) * C + c0;
                    u32x4 px, py; px.x = cvt_pk_bf16(X[0], X[1]); px.y = cvt_pk_bf16(X[2], X[3]); px.z = cvt_pk_bf16(X[4 % NV], X[5 % NV]); px.w = cvt_pk_bf16(X[6 % NV], X[7 % NV]);
                    py.x = cvt_pk_bf16(Y[0], Y[1]); py.y = cvt_pk_bf16(Y[2], Y[3]); py.z = cvt_pk_bf16(Y[4 % NV], Y[5 % NV]); py.w = cvt_pk_bf16(Y[6 % NV], Y[7 % NV]);
                    if (MODE == 0) { *(u32x4*)hx = px; *(u32x4*)hy = py; } else { u32x2 a; a.x = px.x; a.y = px.y; *(u32x2*)hx = a; u32x2 b; b.x = py.x; b.y = py.y; *(u32x2*)hy = b; }
                } else {
                    if (MODE == 0) { u32x4 w; w.x = cvt_pk_bf16(o[0], o[1]); w.y = cvt_pk_bf16(o[2], o[3]); w.z = cvt_pk_bf16(o[4 % NV], o[5 % NV]); w.w = cvt_pk_bf16(o[6 % NV], o[7 % NV]);
                        __builtin_nontemporal_store(w, (u32x4*)(out + (size_t)r * C + c0)); }
                    else { u32x2 w; w.x = cvt_pk_bf16(o[0], o[1]); w.y = cvt_pk_bf16(o[2], o[3]); __builtin_nontemporal_store(w, (u32x2*)(out + (size_t)r * C + c0)); }
                }
                if (m == 3 && fr >= 14) { bf16_t* hx = halo + ((size_t)strip * 6 + (fr - 14)) * C + c0;
                    u32x4 px; px.x = cvt_pk_bf16(X[0], X[1]); px.y = cvt_pk_bf16(X[2], X[3]); px.z = cvt_pk_bf16(X[4 % NV], X[5 % NV]); px.w = cvt_pk_bf16(X[6 % NV], X[7 % NV]);
                    if (MODE == 0) *(u32x4*)hx = px; else { u32x2 a; a.x = px.x; a.y = px.y; *(u32x2*)hx = a; } }
            }
        }
    }
};

struct Params {
    const float* x; const float* norm_mix; const float* norm_ffn; const float* norm_final;
    const float* a_re; const float* a_im; const float* log_dt; const float* b_re; const float* b_im; const float* c_re; const float* c_im; const float* s5_d;
    const float* w_glu; const float* w_in; const float* sc_conv; const float* w_out; const float* w_up; const float* ffn_conv_w; const float* ffn_conv_b; const float* w_down;
    float* out; unsigned char* ws;
};

__device__ __forceinline__ f32x2 cpow_n(float lr, float li, float dt, float n) {
    const float mag = __expf(lr * dt * n);
    double tr = (double)li * (double)dt * (double)n * 0.15915494309189535; tr -= rint(tr);
    const float ang = (float)(tr * 6.283185307179586);
    return (f32x2){mag * cosf(ang), mag * sinf(ang)};
}

__device__ __forceinline__ void s5_precompute(const Params& p, int g, LAS unsigned char* lds) {
    LAS f32x2* pw = (LAS f32x2*)lds;
    LAS f32x2* Bb = pw + 17 * 64;
    LAS f32x2* Cc = Bb + 64 * 16;
    LAS f32x2* Gg = Cc + 16 * 64;
    LAS float* Kt = (LAS float*)(Gg + 64);
    const int tid = otid();
    for (int e = tid; e < 17 * 64; e += 512) { const int d = e >> 6, pp = e & 63; pw[e] = cpow_n(p.a_re[g * 64 + pp], p.a_im[g * 64 + pp], expf(p.log_dt[g]), (float)d); }
    if (tid < 64) {
        const float lr = p.a_re[g * 64 + tid], li = p.a_im[g * 64 + tid], dt = expf(p.log_dt[g]);
        double tr = (double)li * (double)dt * 0.15915494309189535; tr -= rint(tr);
        const float th = (float)(tr * 6.283185307179586);
        const float sh = sinf(0.5f * th), cs = cosf(th), sn = sinf(th);
        const float nr = expm1f(lr * dt) * cs - 2.0f * sh * sh, ni = expf(lr * dt) * sn;
        const float den = lr * lr + li * li;
        Gg[tid] = (f32x2){(nr * lr + ni * li) / den, (ni * lr - nr * li) / den};
    }
    __syncthreads();
    for (int i = tid; i < 1024; i += 512) { const int pp = i >> 4; const f32x2 gg = Gg[pp];
        const float br = p.b_re[(size_t)g * 1024 + i], bi = p.b_im[(size_t)g * 1024 + i];
        Bb[i] = (f32x2){gg.x * br - gg.y * bi, gg.x * bi + gg.y * br};
        Cc[i] = (f32x2){p.c_re[(size_t)g * 1024 + i], p.c_im[(size_t)g * 1024 + i]}; }
    __syncthreads();
    for (int e = tid; e < 4096; e += 512) { const int d = e >> 8, h = (e >> 4) & 15, hp = e & 15; float s = 0.f;
        for (int pp = 0; pp < 64; ++pp) { const f32x2 c = Cc[h * 64 + pp], w = pw[d * 64 + pp], b = Bb[pp * 16 + hp];
            const float tr_ = w.x * b.x - w.y * b.y, ti_ = w.x * b.y + w.y * b.x; s += c.x * tr_ - c.y * ti_; }
        Kt[e] = s; }
    __syncthreads();
    bf16_t* BTA = (bf16_t*)(p.ws + WS_BTA) + (size_t)g * 256 * 256;
    bf16_t* BTB = (bf16_t*)(p.ws + WS_BTB) + (size_t)g * 256 * 384;
    for (int pc = tid; pc < 256 * 32; pc += 512) { const int n = pc >> 5, k0 = (pc & 31) * 8; float v[8];
        const int s = k0 >> 4, hp0 = k0 & 15;
#pragma unroll
        for (int i = 0; i < 8; ++i) { float val = 0.f;
            if (n < 128) { const int pp = n & 63; const f32x2 w = pw[(15 - s) * 64 + pp], b = Bb[pp * 16 + hp0 + i];
                val = n < 64 ? (w.x * b.x - w.y * b.y) : (w.x * b.y + w.y * b.x); }
            v[i] = val; }
        u32x4 w4; w4.x = cvt_pk_bf16(v[0], v[1]); w4.y = cvt_pk_bf16(v[2], v[3]); w4.z = cvt_pk_bf16(v[4], v[5]); w4.w = cvt_pk_bf16(v[6], v[7]);
        *(u32x4*)(BTA + (size_t)n * 256 + k0) = w4; }
    for (int pc = tid; pc < 256 * 48; pc += 512) { const int slot = pc / 48, k0 = (pc % 48) * 8; float v[8];
        const int bj = slot >> 7, wc = (slot >> 5) & 3, nn = (slot >> 4) & 1, fq = (slot >> 2) & 3, j = slot & 3;
        const int nout = 128 * bj + 32 * wc + 8 * fq + 4 * nn + j, t = nout >> 4, h = nout & 15;
        if (k0 < 256) { const int s = k0 >> 4, hp0 = k0 & 15;
#pragma unroll
            for (int i = 0; i < 8; ++i) v[i] = s <= t ? Kt[((t - s) * 16 + h) * 16 + hp0 + i] : 0.f;
        } else { const int kp0 = k0 - 256;
#pragma unroll
            for (int i = 0; i < 8; ++i) { const int kp = kp0 + i, pp = kp & 63; const f32x2 c = Cc[h * 64 + pp], w = pw[(t + 1) * 64 + pp];
                v[i] = kp < 64 ? (c.x * w.x - c.y * w.y) : -(c.x * w.y + c.y * w.x); } }
        u32x4 w4; w4.x = cvt_pk_bf16(v[0], v[1]); w4.y = cvt_pk_bf16(v[2], v[3]); w4.z = cvt_pk_bf16(v[4], v[5]); w4.w = cvt_pk_bf16(v[6], v[7]);
        *(u32x4*)(BTB + (size_t)slot * 384 + k0) = w4; }
    __syncthreads();
}

__device__ __forceinline__ int dest_row(int kind, int n, int NPART) {
    if (kind == 0) { const int part = n / NPART, c = n % NPART, pn = c >> 7, cc = c & 127, wc = cc >> 5, r = cc & 31, fq = r >> 3, nn = (r >> 2) & 1, j = r & 3; return pn * 256 + 128 * part + 32 * wc + 16 * nn + 4 * fq + j; }
    if (kind == 1) { const int q = n >> 10, c = n & 1023, pn = c >> 6, cc = c & 63, wc = cc >> 4, r = cc & 15, fq = r >> 2, j = r & 3; return pn * 256 + 128 * (q >> 1) + 32 * wc + 16 * (q & 1) + 4 * fq + j; }
    const int pn = n >> 8, cc = n & 255, bj = cc >> 7, r2 = cc & 127, wc = r2 >> 5, r = r2 & 31, fq = r >> 3, nn = (r >> 2) & 1, j = r & 3; return pn * 256 + 128 * bj + 32 * wc + 16 * nn + 4 * fq + j;
}
constexpr int PI_S5 = 64, PI_GLU = 16 * 8, PI_UP = 16 * 22, PI_DN = 44 * 4, PI_IN = 16 * 12, PI_OUT = 16 * 4;
constexpr int PO_GLU = PI_S5, PO_UP0 = PO_GLU + PI_GLU, PO_UP1 = PO_UP0 + PI_UP, PO_DN0 = PO_UP1 + PI_UP, PO_DN1 = PO_DN0 + PI_DN, PO_IN = PO_DN1 + PI_DN, PO_OUT = PO_IN + PI_IN, PO_NORM = PO_OUT + PI_OUT, PI_ALL = PO_NORM + NROW;
struct WDesc { const float* W; int K, N; bf16_t* Bt; const float* gain; int kind, NPART, kb, nb; };
__device__ __forceinline__ bool item_desc(const Params& p, int it, WDesc& d) {
    if (it >= PO_NORM) return false;
    if (it < PO_UP0) { const int j = it - PO_GLU; d = WDesc{p.w_glu, 1024, 2048, (bf16_t*)(p.ws + WS_WGLU), nullptr, 0, 1024, j / 8, j % 8}; }
    else if (it < PO_UP1) { const int j = it - PO_UP0; d = WDesc{p.w_up, 1024, 5632, (bf16_t*)(p.ws + WS_WUP0), p.norm_ffn, 0, 2816, j / 22, j % 22}; }
    else if (it < PO_DN0) { const int j = it - PO_UP1; d = WDesc{p.w_up + (size_t)1024 * 5632, 1024, 5632, (bf16_t*)(p.ws + WS_WUP1), p.norm_ffn + 1024, 0, 2816, j / 22, j % 22}; }
    else if (it < PO_DN1) { const int j = it - PO_DN0; d = WDesc{p.w_down, 2816, 1024, (bf16_t*)(p.ws + WS_WDN0), nullptr, 2, 0, j / 4, j % 4}; }
    else if (it < PO_IN) { const int j = it - PO_DN1; d = WDesc{p.w_down + (size_t)2816 * 1024, 2816, 1024, (bf16_t*)(p.ws + WS_WDN1), nullptr, 2, 0, j / 4, j % 4}; }
    else if (it < PO_OUT) { const int j = it - PO_IN; d = WDesc{p.w_in, 1024, 3072, (bf16_t*)(p.ws + WS_WIN), p.norm_mix + 1024, 1, 0, j / 12, j % 12}; }
    else { const int j = it - PO_OUT; d = WDesc{p.w_out, 1024, 1024, (bf16_t*)(p.ws + WS_WOUT), nullptr, 2, 0, j / 4, j % 4}; }
    return true;
}
__device__ __forceinline__ void item_load(const Params& p, int it, f32x4 (&v)[8]) {
    const int tid = otid(); WDesc d;
    if (item_desc(p, it, d)) {
#pragma unroll
        for (int i = 0; i < 8; ++i) { const int idx = tid + i * 512, row = idx >> 6, c4 = idx & 63;
            v[i] = __builtin_nontemporal_load((const f32x4*)(d.W + (size_t)(d.kb * 64 + row) * d.N + d.nb * 256 + c4 * 4)); }
    } else {
        const int R = it - PO_NORM, wid = tid >> 6, lane = tid & 63;
#pragma unroll
        for (int q = 0; q < 2; ++q)
#pragma unroll
            for (int i = 0; i < 4; ++i) v[q * 4 + i] = __builtin_nontemporal_load((const f32x4*)(p.x + ((size_t)R * 16 + wid * 2 + q) * DM + i * 256 + lane * 4));
    }
}
__device__ __forceinline__ void item_finish(const Params& p, int it, const f32x4 (&v)[8], LAS unsigned char* lds) {
    const int tid = otid(); WDesc d;
    if (item_desc(p, it, d)) {
        LAS float* tile = (LAS float*)lds;
#pragma unroll
        for (int i = 0; i < 8; ++i) { const int idx = tid + i * 512, row = idx >> 6, c4 = idx & 63; f32x4 x = v[i];
            if (d.gain) { const float gk = d.gain[d.kb * 64 + row]; x *= gk; }
            tile[row * 257 + c4 * 4 + 0] = x[0]; tile[row * 257 + c4 * 4 + 1] = x[1]; tile[row * 257 + c4 * 4 + 2] = x[2]; tile[row * 257 + c4 * 4 + 3] = x[3]; }
        __syncthreads();
#pragma unroll
        for (int i = 0; i < 4; ++i) { const int idx = tid + i * 512, col = idx >> 3, piece = idx & 7; float t[8];
#pragma unroll
            for (int k = 0; k < 8; ++k) t[k] = tile[(piece * 8 + k) * 257 + col];
            u32x4 w4; w4.x = cvt_pk_bf16(t[0], t[1]); w4.y = cvt_pk_bf16(t[2], t[3]); w4.z = cvt_pk_bf16(t[4], t[5]); w4.w = cvt_pk_bf16(t[6], t[7]);
            *(u32x4*)(d.Bt + (size_t)dest_row(d.kind, d.nb * 256 + col, d.NPART) * d.K + d.kb * 64 + piece * 8) = w4; }
        __syncthreads();
    } else {
        const int R = it - PO_NORM, wid = tid >> 6, lane = tid & 63; bf16_t* AP = (bf16_t*)(p.ws + WS_AP);
#pragma unroll
        for (int q = 0; q < 2; ++q) { const int s = wid * 2 + q; float ss = 0.f;
#pragma unroll
            for (int i = 0; i < 4; ++i) { const f32x4 x = v[q * 4 + i]; ss += (x[0] * x[0] + x[1] * x[1]) + (x[2] * x[2] + x[3] * x[3]); }
#pragma unroll
            for (int o = 32; o >= 1; o >>= 1) ss += __shfl_xor(ss, o);
            const float rs = rsqrtf(ss * (1.0f / DM) + RMS_EPS);
#pragma unroll
            for (int i = 0; i < 4; ++i) { const int c = i * 256 + lane * 4; const f32x4 gn = *(const f32x4*)(p.norm_mix + c); const f32x4 x = v[q * 4 + i];
                u32x2 w; w.x = cvt_pk_bf16(x[0] * rs * gn[0], x[1] * rs * gn[1]); w.y = cvt_pk_bf16(x[2] * rs * gn[2], x[3] * rs * gn[3]);
                *(u32x2*)(AP + ((size_t)(c >> 4) * NROW + R) * KA + s * 16 + (c & 15)) = w; } }
    }
}
__device__ __forceinline__ void run_items(const Params& p, int it0, int step, int end, LAS unsigned char* lds) {
    if (it0 >= end) return;
    f32x4 cur[8], nxt[8];
    item_load(p, it0, cur);
    for (int it = it0; it < end; it += step) {
        const bool more = it + step < end;
        if (more) item_load(p, it + step, nxt);
        item_finish(p, it, cur, lds);
        if (more) {
#pragma unroll
            for (int i = 0; i < 8; ++i) cur[i] = nxt[i]; }
    }
}

__device__ __forceinline__ void prep_phase(const Params& p, LAS unsigned char* lds) {
    const int G = gridDim.x, bid = blockIdx.x, tid = otid();
    { float* ssq = (float*)(p.ws + WS_SSQ); for (int i = bid * 512 + tid; i < 4 * MTOK; i += G * 512) ssq[i] = 0.f;
      bf16_t* WIN = (bf16_t*)(p.ws + WS_WIN);
      for (int i = bid * 512 + tid; i < 1024 * 128; i += G * 512) { const int zr = i >> 7, piece = i & 127;
          const int pn = zr >> 6, wc = (zr >> 4) & 3, rr = zr & 15; const int row = pn * 256 + 128 + 32 * wc + 16 + rr;
          *(u32x4*)(WIN + (size_t)row * 1024 + piece * 8) = (u32x4){0u, 0u, 0u, 0u}; } }
    int first = PI_S5;
    if (G > PI_S5) {
        if (bid < PI_S5) s5_precompute(p, bid, lds);
        else { const int e10 = PI_S5 + 13 * (G - PI_S5); run_items(p, PI_S5 + (bid - PI_S5), G - PI_S5, e10 < PI_ALL ? e10 : PI_ALL, lds); }
        first = PI_S5 + 13 * (G - PI_S5);
    } else for (int it = bid; it < PI_S5; it += G) s5_precompute(p, it, lds);
    run_items(p, first + bid, G, PI_ALL, lds);
}

__device__ __forceinline__ void scan_item(const Params& p, int g, int b, LAS unsigned char* lds) {
    LAS f32x2* E = (LAS f32x2*)lds;
    const int tid = otid(), pp = tid & 63, seg = __builtin_amdgcn_readfirstlane(tid >> 6);
    const float* S = (const float*)(p.ws + WS_S); bf16_t* AP = (bf16_t*)(p.ws + WS_AP);
    const float lr = p.a_re[g * 64 + pp], li = p.a_im[g * 64 + pp], dt = expf(p.log_dt[g]);
    f32x2 A16 = cpow_n(lr, li, dt, 16.f), A1k = cpow_n(lr, li, dt, 1024.f);
    const size_t row0 = (size_t)g * NROW + b * 512 + seg * 64;
    asm volatile("" : "+v"(A16), "+v"(A1k) :: "memory");
    const __amdgpu_buffer_rsrc_t rs = __builtin_amdgcn_make_buffer_rsrc((void*)(S + row0 * 128), (short)0, 0x7fffffff, 0x00020000);
    constexpr int NREG = 48;
    float sr[NREG], si[NREG], tr[64 - NREG], ti[64 - NREG];
#pragma unroll
    for (int c = 0; c < NREG; ++c) { sr[c] = __uint_as_float(__builtin_amdgcn_raw_buffer_load_b32(rs, pp * 4, c * 512, 0)); si[c] = __uint_as_float(__builtin_amdgcn_raw_buffer_load_b32(rs, pp * 4, c * 512 + 256, 0)); }
#pragma unroll
    for (int c = NREG; c < 64; ++c) { tr[c - NREG] = __uint_as_float(__builtin_amdgcn_raw_buffer_load_b32(rs, pp * 4, c * 512, 0)); ti[c - NREG] = __uint_as_float(__builtin_amdgcn_raw_buffer_load_b32(rs, pp * 4, c * 512 + 256, 0)); }
    float xr = 0.f, xi = 0.f;
#pragma unroll
    for (int c = 0; c < NREG; ++c) { const float nr = A16.x * xr - A16.y * xi + sr[c], ni = A16.x * xi + A16.y * xr + si[c]; xr = nr; xi = ni; }
#pragma unroll
    for (int c = NREG; c < 64; ++c) { const float nr = A16.x * xr - A16.y * xi + tr[c - NREG], ni = A16.x * xi + A16.y * xr + ti[c - NREG]; xr = nr; xi = ni; }
    E[seg * 64 + pp] = (f32x2){xr, xi};
    asm volatile("" ::: "memory");
#pragma unroll
    for (int c = NREG; c < 64; ++c) { tr[c - NREG] = __uint_as_float(__builtin_amdgcn_raw_buffer_load_b32(rs, pp * 4, c * 512, 0)); ti[c - NREG] = __uint_as_float(__builtin_amdgcn_raw_buffer_load_b32(rs, pp * 4, c * 512 + 256, 0)); }
    __syncthreads();
    xr = 0.f; xi = 0.f;
    for (int j = 0; j < seg; ++j) { const f32x2 e = E[j * 64 + pp]; const float nr = A1k.x * xr - A1k.y * xi + e.x, ni = A1k.x * xi + A1k.y * xr + e.y; xr = nr; xi = ni; }
    const __amdgpu_buffer_rsrc_t rd = __builtin_amdgcn_make_buffer_rsrc((void*)(AP + row0 * KA + 256), (short)0, 0x7fffffff, 0x00020000);
#pragma unroll
    for (int c = 0; c < 64; ++c) {
        __builtin_amdgcn_raw_buffer_store_b16((short)(cvt_pk_bf16(xr, xr) & 0xffffu), rd, pp * 2, c * (KA * 2), 0); __builtin_amdgcn_raw_buffer_store_b16((short)(cvt_pk_bf16(xi, xi) & 0xffffu), rd, pp * 2, c * (KA * 2) + 128, 0);
        const float a = c < NREG ? sr[c < NREG ? c : 0] : tr[c < NREG ? 0 : c - NREG], bq = c < NREG ? si[c < NREG ? c : 0] : ti[c < NREG ? 0 : c - NREG];
        const float nr = A16.x * xr - A16.y * xi + a, ni = A16.x * xi + A16.y * xr + bq; xr = nr; xi = ni; }
    __syncthreads();
}

template <int MODE, class Sched> __device__ __forceinline__ void fixup_local(const bf16_t* halo, const float* cw, const float* cb, bf16_t* out, int C, const Sched& S) {
    const int C4 = C >> 2, tid = otid(); Unit u;
    for (int i = 0; S.next(i, u); ++i)
        for (int c4 = tid; c4 < C4; c4 += 512) {
            const int c = c4 * 4;
            const f32x4 w0 = *(const f32x4*)(cw + c), w1 = *(const f32x4*)(cw + C + c), w2 = *(const f32x4*)(cw + 2 * C + c);
            f32x4 bb = (f32x4){0.f, 0.f, 0.f, 0.f}; if (MODE == 0) bb = *(const f32x4*)(cb + c);
            f32x4 t0[4], t1[4], h0[4], h1[4], y0[4], y1[4];
#pragma unroll
            for (int k = 0; k < 4; ++k) { const int s = 4 * u.pm + k; const bf16_t* hb = halo + (size_t)s * 6 * C + c; const bool first = (s & 127) == 0;
                const f32x4 z = (f32x4){0.f, 0.f, 0.f, 0.f};
                auto ld4 = [](const bf16_t* ptr) { const u32x2 w = *(const u32x2*)ptr; return (f32x4){bf_lo(w.x), bf_hi(w.x), bf_lo(w.y), bf_hi(w.y)}; };
                t0[k] = ld4(first ? hb : hb - (size_t)6 * C); t1[k] = ld4(first ? hb : hb - (size_t)5 * C);
                if (first) { t0[k] = z; t1[k] = z; }
                h0[k] = ld4(hb + (size_t)2 * C); h1[k] = ld4(hb + (size_t)3 * C);
                y0[k] = ld4(hb + (size_t)4 * C); y1[k] = ld4(hb + (size_t)5 * C); }
#pragma unroll
            for (int k = 0; k < 4; ++k) { const int s = 4 * u.pm + k; float o0[4], o1[4];
#pragma unroll
                for (int j = 0; j < 4; ++j) {
                    const float cv0 = w2[j] * h0[k][j] + w1[j] * t1[k][j] + w0[j] * t0[k][j] + bb[j];
                    const float cv1 = w2[j] * h1[k][j] + w1[j] * h0[k][j] + w0[j] * t1[k][j] + bb[j];
                    o0[j] = MODE == 0 ? silu_f(cv0) * y0[k][j] : cv0 * y0[k][j]; o1[j] = MODE == 0 ? silu_f(cv1) * y1[k][j] : cv1 * y1[k][j]; }
                u32x2 a; a.x = cvt_pk_bf16(o0[0], o0[1]); a.y = cvt_pk_bf16(o0[2], o0[3]); u32x2 b; b.x = cvt_pk_bf16(o1[0], o1[1]); b.y = cvt_pk_bf16(o1[2], o1[3]);
                *(u32x2*)(out + ((size_t)s * 64) * C + c) = a; *(u32x2*)(out + ((size_t)s * 64 + 1) * C + c) = b; }
        }
    asm volatile("s_waitcnt vmcnt(0)" ::: "memory");
    __syncthreads();
}

__device__ __forceinline__ void final_phase(float* out, const bf16_t* HB, const float* ssq, const float* gf) {
    for (int idx = blockIdx.x * 512 + otid(); idx < MTOK * 128; idx += gridDim.x * 512) {
        const int r = idx >> 7, c = (idx & 127) * 8;
        const float rs = rsqrtf(ssq[r] * (1.0f / DM) + RMS_EPS);
        const u32x4 q = __builtin_nontemporal_load((const u32x4*)(HB + (size_t)idx * 8)); const f32x4 g0 = *(const f32x4*)(gf + c), g1 = *(const f32x4*)(gf + c + 4);
        f32x4 v0 = (f32x4){bf_lo(q.x), bf_hi(q.x), bf_lo(q.y), bf_hi(q.y)}, v1 = (f32x4){bf_lo(q.z), bf_hi(q.z), bf_lo(q.w), bf_hi(q.w)};
        v0 *= g0 * rs; v1 *= g1 * rs;
        __builtin_nontemporal_store(v0, (f32x4*)(out + (size_t)idx * 8)); __builtin_nontemporal_store(v1, (f32x4*)(out + (size_t)idx * 8 + 4));
    }
}

__global__ void __launch_bounds__(512, 2) fwd_megakernel(Params p) {
    extern __shared__ __attribute__((aligned(16))) unsigned char smem[];
    LAS unsigned char* lds = (LAS unsigned char*)smem;
    unsigned* bar = (unsigned*)(p.ws + WS_CTL);
    volatile LAS unsigned* xst = (volatile LAS unsigned*)(lds + STAGE_BYTES);
    const unsigned xcc = xb_xcc_id();
    if (threadIdx.x == 0) { xst[0] = 0u; xst[1] = 0u; (void)xb_add(&bar[XB_XCNT(xcc)], 1u); }
    __syncthreads();
#define GRID_SYNC() grid_bar(bar, xcc, xst)
    float* ssq = (float*)(p.ws + WS_SSQ);
    bf16_t* AP = (bf16_t*)(p.ws + WS_AP); float* Sbuf = (float*)(p.ws + WS_S);
    bf16_t* Z = (bf16_t*)(p.ws + WS_Z); bf16_t* HB = (bf16_t*)(p.ws + WS_HB); bf16_t* ACT = (bf16_t*)(p.ws + WS_ACT);
    bf16_t* halo = (bf16_t*)(p.ws + WS_HALO);

    prep_phase(p, lds);
    if (p.ws == nullptr) cg::this_grid().sync();
    GRID_SYNC();
    for (int it = blockIdx.x; it < NG * 4; it += gridDim.x) {
        S5PairOrder S; S.init(it, 256); EpiS5a E{Sbuf}; gemm_phase<0>(lds, AP, KA, (const bf16_t*)(p.ws + WS_BTA), 256, S, E);
        asm volatile("s_waitcnt vmcnt(0)" ::: "memory"); __syncthreads();
        scan_item(p, it >> 2, it & 3, lds);
    }
    GRID_SYNC();
    { S5Order S; S.init(384); EpiS5b E{AP, p.s5_d, Z}; gemm_phase(lds, AP, KA, (const bf16_t*)(p.ws + WS_BTB), 384, S, E); }
    GRID_SYNC();
    { StdOrder S; S.init(MTOK, 2048, 1024, 1024); EpiGlu E{p.x, HB, ssq}; gemm_phase(lds, Z, 1024, (const bf16_t*)(p.ws + WS_WGLU), 1024, S, E); }
    GRID_SYNC();
    { StdOrder S; S.init(MTOK, 5632, 1024, 1024); EpiConv<0> E{ssq, p.ffn_conv_w, p.ffn_conv_b, ACT, halo, DFF}; gemm_phase(lds, HB, 1024, (const bf16_t*)(p.ws + WS_WUP0), 1024, S, E); }
    GRID_SYNC();
    { StdOrder S; S.init(MTOK, 1024, 2816, 2816); fixup_local<0>(halo, p.ffn_conv_w, p.ffn_conv_b, ACT, DFF, S); EpiRes<false> E{HB, ssq + MTOK}; gemm_phase(lds, ACT, 2816, (const bf16_t*)(p.ws + WS_WDN0), 2816, S, E); }
    GRID_SYNC();
    { StdOrder S; S.init(MTOK, 4096, 1024, 1024); EpiConv<1> E{ssq + MTOK, p.sc_conv, nullptr, Z, halo, DM}; gemm_phase<1>(lds, HB, 1024, (const bf16_t*)(p.ws + WS_WIN), 1024, S, E); }
    GRID_SYNC();
    { StdOrder S; S.init(MTOK, 1024, 1024, 1024); fixup_local<1>(halo, p.sc_conv, nullptr, Z, DM, S); EpiRes<false> E{HB, ssq + 2 * MTOK}; gemm_phase(lds, Z, 1024, (const bf16_t*)(p.ws + WS_WOUT), 1024, S, E); }
    GRID_SYNC();
    { StdOrder S; S.init(MTOK, 5632, 1024, 1024); EpiConv<0> E{ssq + 2 * MTOK, p.ffn_conv_w + 3 * DFF, p.ffn_conv_b + DFF, ACT, halo, DFF}; gemm_phase(lds, HB, 1024, (const bf16_t*)(p.ws + WS_WUP1), 1024, S, E); }
    GRID_SYNC();
    { StdOrder S; S.init(MTOK, 1024, 2816, 2816); fixup_local<0>(halo, p.ffn_conv_w + 3 * DFF, p.ffn_conv_b + DFF, ACT, DFF, S); EpiRes<true> E{HB, ssq + 3 * MTOK}; gemm_phase(lds, ACT, 2816, (const bf16_t*)(p.ws + WS_WDN1), 2816, S, E); }
    GRID_SYNC();
    final_phase(p.out, HB, ssq + 3 * MTOK, p.norm_final);
#undef GRID_SYNC
}

extern "C" void kernel_launch(void* const* d_in, const int* in_sizes, int n_in, void* d_out, int out_size, void* d_ws, size_t ws_size, hipStream_t stream) {
    constexpr int LDS_BYTES = STAGE_BYTES + 64 + 8192;
    static int grid = 0;
    if (grid == 0) {
        if (n_in != 20 || out_size != MTOK * DM || ws_size < WS_END) { fprintf(stderr, "kernel_launch: unexpected shapes (n_in %d out %d ws %zu need %zu)\n", n_in, out_size, ws_size, (size_t)WS_END); grid = -1; return; }
        int dev = 0, cus = 0, per_cu = 0;
        (void)hipGetDevice(&dev); (void)hipDeviceGetAttribute(&cus, hipDeviceAttributeMultiprocessorCount, dev);
        if (hipFuncSetAttribute((const void*)fwd_megakernel, hipFuncAttributeMaxDynamicSharedMemorySize, LDS_BYTES) != hipSuccess) { fprintf(stderr, "kernel_launch: hipFuncSetAttribute failed\n"); grid = -1; return; }
        (void)hipOccupancyMaxActiveBlocksPerMultiprocessor(&per_cu, (const void*)fwd_megakernel, 512, LDS_BYTES);
        if (per_cu < 1) { fprintf(stderr, "kernel_launch: occupancy query says %d blocks per CU\n", per_cu); per_cu = 1; }
        (void)hipGetLastError();
        grid = cus;
    }
    if (grid < 0) return;
    (void)hipMemsetAsync((char*)d_ws + WS_CTL, 0, 16384, stream);
    Params p{};
    p.x = (const float*)d_in[0]; p.norm_mix = (const float*)d_in[1]; p.norm_ffn = (const float*)d_in[2]; p.norm_final = (const float*)d_in[3];
    p.a_re = (const float*)d_in[4]; p.a_im = (const float*)d_in[5]; p.log_dt = (const float*)d_in[6]; p.b_re = (const float*)d_in[7]; p.b_im = (const float*)d_in[8];
    p.c_re = (const float*)d_in[9]; p.c_im = (const float*)d_in[10]; p.s5_d = (const float*)d_in[11]; p.w_glu = (const float*)d_in[12];
    p.w_in = (const float*)d_in[13]; p.sc_conv = (const float*)d_in[14]; p.w_out = (const float*)d_in[15];
    p.w_up = (const float*)d_in[16]; p.ffn_conv_w = (const float*)d_in[17]; p.ffn_conv_b = (const float*)d_in[18]; p.w_down = (const float*)d_in[19];
    p.out = (float*)d_out; p.ws = (unsigned char*)d_ws;
    void* args[] = {&p};
    hipError_t e = hipLaunchCooperativeKernel((const void*)fwd_megakernel, dim3(grid), dim3(512), args, LDS_BYTES, stream);
    if (e != hipSuccess) fprintf(stderr, "cooperative launch failed: %s (grid %d)\n", hipGetErrorString(e), grid);
}
```
